# Optimizing an MI355X kernel written in HIP

```python
import jax
import jax.numpy as jnp
from jax import lax
import numpy as np

D_MODEL = 1024
BATCH = 4
SEQ = 4096
DEPTH = 4

GRID_W = 64
CTX_LEN = 256
D_FF = 4 * D_MODEL
CHUNK = 64
NORM_EPS = 1e-6
HEAD_NORM_EPS = 1e-5
N_MOD = 6

RWKV_HEAD = 64
RWKV_WIDTH = D_MODEL
RWKV_HEADS = RWKV_WIDTH // RWKV_HEAD
DECAY_LORA = 64
AAA_LORA = 64
MV_LORA = 32
GATE_LORA = 128
RWKV_GN_EPS = 64e-5

GLA_HEADS = 4
GLA_QK = D_MODEL // 2
GLA_V = D_MODEL
GLA_QK_HEAD = GLA_QK // GLA_HEADS
GLA_V_HEAD = GLA_V // GLA_HEADS
GLA_GATE_RANK = 16
GLA_TAU = 16.0

RET_HEADS = 4
RET_QK = D_MODEL
RET_V = D_MODEL
RET_QK_HEAD = RET_QK // RET_HEADS
RET_V_HEAD = RET_V // RET_HEADS
ROPE_BASE = 10000.0

N_BRANCH = 3
RWKV_COLS = (RWKV_WIDTH, RWKV_WIDTH, RWKV_WIDTH, DECAY_LORA, DECAY_LORA, AAA_LORA, GATE_LORA)
GLA_COLS = (GLA_QK, GLA_QK, GLA_V, GLA_V, GLA_GATE_RANK, GLA_GATE_RANK)
RET_COLS = (RET_QK, RET_QK, RET_V, RET_V)
RWKV_IN = 3 * RWKV_WIDTH + 2 * DECAY_LORA + AAA_LORA + GATE_LORA
GLA_IN = 2 * GLA_QK + 2 * GLA_V + 2 * GLA_GATE_RANK
RET_IN = 2 * RET_QK + 2 * RET_V
GATE_IN = N_BRANCH * D_MODEL
D_IN = RWKV_IN + GLA_IN + RET_IN + GATE_IN

kernel_name = 'hybrid_rwkv7_gla_retention_dit'


def split_cols(t, sizes):
    return jnp.split(t, [int(i) for i in np.cumsum(sizes)[:-1]], axis=-1)


def heads(t, h):
    return t.reshape(t.shape[:-1] + (h, t.shape[-1] // h))


def rms_norm(x, g):
    xf = x.astype(jnp.float32)
    y = xf * lax.rsqrt(jnp.mean(jnp.square(xf), -1, keepdims=True) + NORM_EPS)
    return y.astype(x.dtype) * g


def modulate(h, shift, scale):
    return h * (1.0 + scale) + shift


def head_norm(o, gain, bias, eps, center):
    b, t, h, d = o.shape
    of = o.astype(jnp.float32)
    if center:
        of = of - jnp.mean(of, -1, keepdims=True)
    y = of * lax.rsqrt(jnp.mean(jnp.square(of), -1, keepdims=True) + eps)
    y = y.reshape(b, t, h * d).astype(o.dtype) * gain
    return y if bias is None else y + bias


def rotary(t, pos):
    half = t.shape[-1] // 2
    inv_freq = ROPE_BASE ** (-jnp.arange(half, dtype=jnp.float32) / half)
    ang = pos[:, None] * inv_freq[None, :]
    cos = jnp.cos(ang)[None, :, None, :].astype(t.dtype)
    sin = jnp.sin(ang)[None, :, None, :].astype(t.dtype)
    t1, t2 = t[..., :half], t[..., half:]
    return jnp.concatenate([t1 * cos - t2 * sin, t1 * sin + t2 * cos], -1)


def shift_ctx(p):
    b, t, ch = p.shape
    g = p.reshape(b, t, ch // 2, 2)
    prev = jnp.pad(g[:, :-1, :, 0], ((0, 0), (1, 0), (0, 0)))
    nxt = jnp.pad(g[:, 1:, :, 1], ((0, 0), (0, 1), (0, 0)))
    return jnp.stack([prev, nxt], -1).reshape(b, t, ch)


def shift_grid(p, rows):
    b, t, ch = p.shape
    g = p.reshape(b, rows, GRID_W, ch // 4, 4)
    left = jnp.pad(g[:, :, :-1, :, 0], ((0, 0), (0, 0), (1, 0), (0, 0)))
    right = jnp.pad(g[:, :, 1:, :, 1], ((0, 0), (0, 0), (0, 1), (0, 0)))
    up = jnp.pad(g[:, :-1, :, :, 2], ((0, 0), (1, 0), (0, 0), (0, 0)))
    down = jnp.pad(g[:, 1:, :, :, 3], ((0, 0), (0, 1), (0, 0), (0, 0)))
    return jnp.stack([left, right, up, down], -1).reshape(b, t, ch)


def rwkv7_scan(r, decay, k, v, kk, a, s0):
    dt = v.dtype
    xs = tuple(jnp.moveaxis(t.astype(jnp.float32), 1, 0) for t in (r, decay, k, v, kk, a))

    def step(s, inp):
        r_t, w_t, k_t, v_t, kk_t, a_t = inp
        s_kk = jnp.einsum('bhvk,bhk->bhv', s, kk_t)
        s = (s * w_t[:, :, None, :] - s_kk[..., None] * (kk_t * a_t)[:, :, None, :]
             + v_t[..., None] * k_t[:, :, None, :])
        return s, jnp.einsum('bhvk,bhk->bhv', s, r_t)

    s_fin, o = lax.scan(step, s0, xs)
    return jnp.moveaxis(o, 0, 1).astype(dt), s_fin


def chunked_gated_scan(q, k, v, log_g, s0):
    dt = v.dtype
    b, t, h, _ = q.shape
    dv = v.shape[-1]
    n = t // CHUNK
    q, k, v, log_g = (z.astype(jnp.float32).reshape(b, n, CHUNK, h, z.shape[-1]) for z in (q, k, v, log_g))
    cum = jnp.cumsum(log_g, axis=2)
    last = cum[:, :, -1:]
    q_in = q * jnp.exp(cum)
    k_in = k * jnp.exp(-cum)
    k_out = k * jnp.exp(last - cum)
    lower = jnp.tril(jnp.ones((CHUNK, CHUNK), dtype=bool))
    scores = jnp.where(lower, jnp.einsum('bnchd,bnshd->bnhcs', q_in, k_in), 0.0)
    intra = jnp.einsum('bnhcs,bnshv->bnchv', scores, v)
    kv = jnp.einsum('bnshd,bnshv->bnhdv', k_out, v)

    def step(s, inp):
        dec, kv_n = inp
        return dec[..., None] * s + kv_n, s

    s_fin, s_prev = lax.scan(step, s0, (jnp.moveaxis(jnp.exp(last[:, :, 0]), 1, 0), jnp.moveaxis(kv, 1, 0)))
    inter = jnp.einsum('bnchd,nbhdv->bnchv', q_in, s_prev)
    return (intra + inter).reshape(b, t, h, dv).astype(dt), s_fin


def ctx_then_latent(scan_fn, args_c, args_l, s0, reverse):
    if reverse:
        args_c = tuple(jnp.flip(t, 1) for t in args_c)
        args_l = tuple(jnp.flip(t, 1) for t in args_l)
    o_c, s_c = scan_fn(*args_c, s0)
    o_l, _ = scan_fn(*args_l, s_c)
    if reverse:
        o_c, o_l = jnp.flip(o_c, 1), jnp.flip(o_l, 1)
    return o_c, o_l


def bidirectional(scan_fn, fwd_c, fwd_l, bwd_c, bwd_l, s0):
    of_c, of_l = ctx_then_latent(scan_fn, fwd_c, fwd_l, s0, False)
    ob_c, ob_l = ctx_then_latent(scan_fn, bwd_c, bwd_l, s0, True)
    return of_c + ob_c, of_l + ob_l


def rwkv7_stream(p, shifted, v_first, vres, mu, w0, w2, a0, a2, g2, k_k, k_a):
    p = p + (shifted - p) * mu
    r, k, v, wd_f, wd_b, a_d, g_d = split_cols(p, RWKV_COLS)
    if vres is not None:
        v0, v1, v2 = vres
        v = v + (v_first - v) * jax.nn.sigmoid(v0 + (v @ v1) @ v2)
    dec_f, dec_b = (jnp.exp(-jnp.exp(-jax.nn.softplus(-(w0[d] + jnp.tanh(wd) @ w2[d])) - 0.5))
                    for d, wd in enumerate((wd_f, wd_b)))
    a = jax.nn.sigmoid(a0 + a_d @ a2)
    g = jax.nn.sigmoid(g_d) @ g2
    kk = heads(k * k_k, RWKV_HEADS)
    kk = kk * lax.rsqrt(jnp.maximum(jnp.sum(jnp.square(kk.astype(jnp.float32)), -1, keepdims=True), 1e-12)).astype(kk.dtype)
    k = k * (1.0 + (a - 1.0) * k_a)
    hd = lambda t: heads(t, RWKV_HEADS)
    return (hd(r), hd(dec_f), hd(dec_b), hd(k), hd(v), kk, hd(a), g, v)


def rwkv7_mixer(p_c, p_l, rows, v_first, vres, ctx_out, mu, w0, w2, a0, a2, g2, k_k, k_a, r_k, ln_g, ln_b):
    vf_c, vf_l = (None, None) if v_first is None else v_first
    sc = rwkv7_stream(p_c, shift_ctx(p_c), vf_c, vres, mu, w0, w2, a0, a2, g2, k_k, k_a)
    sl = rwkv7_stream(p_l, shift_grid(p_l, rows), vf_l, vres, mu, w0, w2, a0, a2, g2, k_k, k_a)
    s0 = jnp.zeros((p_c.shape[0], RWKV_HEADS, RWKV_HEAD, RWKV_HEAD), jnp.float32)
    fwd = lambda s: (s[0], s[1], s[3], s[4], s[5], s[6])
    bwd = lambda s: (s[0], s[2], s[3], s[4], s[5], s[6])
    o_c, o_l = bidirectional(rwkv7_scan, fwd(sc), fwd(sl), bwd(sc), bwd(sl), s0)

    def finish(o, s):
        r, k, v, g = s[0], s[3], s[4], s[7]
        y = head_norm(o, ln_g, ln_b, RWKV_GN_EPS, True)
        bonus = jnp.sum(r * k * r_k, -1, keepdims=True) * v
        return (y + bonus.reshape(y.shape)) * g

    out_c = finish(o_c, sc) if ctx_out else None
    return out_c, finish(o_l, sl), (sc[8], sl[8])


def gla_stream(p, a2, a_b):
    q, k, v, r, ad_f, ad_b = split_cols(p, GLA_COLS)
    lg_f, lg_b = (jax.nn.log_sigmoid(ad @ a2[d] + a_b[d]) / GLA_TAU for d, ad in enumerate((ad_f, ad_b)))
    hd = lambda t: heads(t, GLA_HEADS)
    return (hd(q * GLA_QK_HEAD ** -0.5), hd(k), hd(v), hd(lg_f), hd(lg_b), r)


def gla_mixer(p_c, p_l, ctx_out, a2, a_b, norm_g):
    sc, sl = gla_stream(p_c, a2, a_b), gla_stream(p_l, a2, a_b)
    s0 = jnp.zeros((p_c.shape[0], GLA_HEADS, GLA_QK_HEAD, GLA_V_HEAD), jnp.float32)
    fwd = lambda s: (s[0], s[1], s[2], s[3])
    bwd = lambda s: (s[0], s[1], s[2], s[4])
    o_c, o_l = bidirectional(chunked_gated_scan, fwd(sc), fwd(sl), bwd(sc), bwd(sl), s0)
    finish = lambda o, s: head_norm(o, norm_g, None, HEAD_NORM_EPS, False) * jax.nn.silu(s[5])
    out_c = finish(o_c, sc) if ctx_out else None
    return out_c, finish(o_l, sl)


def retention_stream(p, pos):
    q, k, v, g = split_cols(p, RET_COLS)
    q = rotary(heads(q, RET_HEADS), pos)
    k = rotary(heads(k, RET_HEADS), pos) * RET_QK_HEAD ** -0.5
    return (q, k, heads(v, RET_HEADS), g)


def retention_mixer(p_c, p_l, ctx_out, decay_param, norm_g):
    n_c, n_l = p_c.shape[1], p_l.shape[1]
    sc = retention_stream(p_c, jnp.arange(n_c, dtype=jnp.float32))
    sl = retention_stream(p_l, n_c + jnp.arange(n_l, dtype=jnp.float32))
    log_gamma = -jnp.exp(decay_param.astype(jnp.float32))
    args = lambda s, d: (s[0], s[1], s[2], jnp.broadcast_to(log_gamma[d][:, None], s[0].shape))
    s0 = jnp.zeros((p_c.shape[0], RET_HEADS, RET_QK_HEAD, RET_V_HEAD), jnp.float32)
    o_c, o_l = bidirectional(chunked_gated_scan, args(sc, 0), args(sl, 0), args(sc, 1), args(sl, 1), s0)
    finish = lambda o, s: head_norm(o, norm_g, None, HEAD_NORM_EPS, True) * jax.nn.silu(s[3])
    out_c = finish(o_c, sc) if ctx_out else None
    return out_c, finish(o_l, sl)


def merge_branches(outs, gate_logits, w_branch, w_out):
    g0, g1, g2 = split_cols(gate_logits, (D_MODEL,) * N_BRANCH)
    o0, o1, o2 = outs
    merged = (jax.nn.sigmoid(g0) * (o0 @ w_branch[0]) + jax.nn.sigmoid(g1) * (o1 @ w_branch[1])
              + jax.nn.sigmoid(g2) * (o2 @ w_branch[2]))
    return merged @ w_out


def squared_relu_mlp(h, w1, w2):
    return jnp.square(jax.nn.relu(h @ w1)) @ w2


def setup_inputs(seed: int = 0) -> dict:
    key = jax.random.key(seed)
    ks = iter(jax.random.split(key, 40))
    nrm = lambda shape, scale: scale * jax.random.normal(next(ks), shape, jnp.float32)
    gain = lambda shape: 1.0 + nrm(shape, 0.01)
    L, D = DEPTH, D_MODEL
    ret_init = np.log(-np.log(1.0 - 2.0 ** (-5.0 - np.arange(RET_HEADS)))).astype(np.float32)
    return {
        'x': nrm((BATCH, SEQ, D), 1.0),
        'c': nrm((BATCH, D), 1.0),
        'ctx': nrm((BATCH, CTX_LEN, D), 1.0),
        'c_ctx': nrm((D,), 1.0),
        'ada_w': nrm((L, D, N_MOD * D), 0.5 * D ** -0.5),
        'ada_b': nrm((L, N_MOD * D), 0.02),
        'norm_pre_mix': gain((L, D)),
        'norm_post_mix': gain((L, D)),
        'norm_pre_mlp': gain((L, D)),
        'norm_post_mlp': gain((L, D)),
        'w_in': nrm((L, D, D_IN), D ** -0.5),
        'rwkv_mu': jax.random.uniform(next(ks), (L, RWKV_IN), jnp.float32, 0.0, 1.0),
        'rwkv_w0': jax.random.uniform(next(ks), (L, 2, RWKV_WIDTH), jnp.float32, -5.0, -1.0),
        'rwkv_w2': nrm((L, 2, DECAY_LORA, RWKV_WIDTH), 0.5 * DECAY_LORA ** -0.5),
        'rwkv_a0': nrm((L, RWKV_WIDTH), 0.5),
        'rwkv_a2': nrm((L, AAA_LORA, RWKV_WIDTH), AAA_LORA ** -0.5),
        'rwkv_g2': nrm((L, GATE_LORA, RWKV_WIDTH), GATE_LORA ** -0.5),
        'rwkv_v0': nrm((L - 1, RWKV_WIDTH), 0.5),
        'rwkv_v1': nrm((L - 1, RWKV_WIDTH, MV_LORA), RWKV_WIDTH ** -0.5),
        'rwkv_v2': nrm((L - 1, MV_LORA, RWKV_WIDTH), MV_LORA ** -0.5),
        'rwkv_k_k': 0.85 + nrm((L, RWKV_WIDTH), 0.05),
        'rwkv_k_a': 1.0 + nrm((L, RWKV_WIDTH), 0.05),
        'rwkv_r_k': nrm((L, RWKV_HEADS, RWKV_HEAD), 0.1),
        'rwkv_ln_g': gain((L, RWKV_WIDTH)),
        'rwkv_ln_b': nrm((L, RWKV_WIDTH), 0.01),
        'gla_a2': nrm((L, 2, GLA_GATE_RANK, GLA_QK), GLA_GATE_RANK ** -0.5),
        'gla_a_b': nrm((L, 2, GLA_QK), 0.1),
        'gla_norm_g': gain((L, GLA_V)),
        'ret_decay': jnp.asarray(ret_init) + nrm((L, 2, RET_HEADS), 0.05),
        'ret_norm_g': gain((L, RET_V)),
        'w_branch': nrm((L, N_BRANCH, D, D), D ** -0.5),
        'w_out': nrm((L, D, D), D ** -0.5),
        'mlp_w1': nrm((L, D, D_FF), D ** -0.5),
        'mlp_w2': nrm((L, D_FF, D), D_FF ** -0.5),
    }


def reference(x, c, ctx, c_ctx, ada_w, ada_b, norm_pre_mix, norm_post_mix, norm_pre_mlp, norm_post_mlp,
              w_in, rwkv_mu, rwkv_w0, rwkv_w2, rwkv_a0, rwkv_a2, rwkv_g2, rwkv_v0, rwkv_v1, rwkv_v2,
              rwkv_k_k, rwkv_k_a, rwkv_r_k, rwkv_ln_g, rwkv_ln_b, gla_a2, gla_a_b, gla_norm_g,
              ret_decay, ret_norm_g, w_branch, w_out, mlp_w1, mlp_w2):
    rows = x.shape[1] // GRID_W
    xl, xc = x, ctx
    v_first = None
    for l in range(DEPTH):
        last = l == DEPTH - 1
        mod_c = split_cols(jax.nn.silu(c_ctx) @ ada_w[l] + ada_b[l], (D_MODEL,) * N_MOD)
        mod_l = split_cols((jax.nn.silu(c) @ ada_w[l] + ada_b[l])[:, None, :], (D_MODEL,) * N_MOD)

        p_c = modulate(rms_norm(xc, norm_pre_mix[l]), mod_c[0], mod_c[1]) @ w_in[l]
        p_l = modulate(rms_norm(xl, norm_pre_mix[l]), mod_l[0], mod_l[1]) @ w_in[l]
        rw_c, gl_c, rt_c, gate_c = split_cols(p_c, (RWKV_IN, GLA_IN, RET_IN, GATE_IN))
        rw_l, gl_l, rt_l, gate_l = split_cols(p_l, (RWKV_IN, GLA_IN, RET_IN, GATE_IN))
        vres = None if l == 0 else (rwkv_v0[l - 1], rwkv_v1[l - 1], rwkv_v2[l - 1])
        a_c, a_l, v_vals = rwkv7_mixer(rw_c, rw_l, rows, v_first, vres, not last, rwkv_mu[l], rwkv_w0[l],
                                       rwkv_w2[l], rwkv_a0[l], rwkv_a2[l], rwkv_g2[l], rwkv_k_k[l],
                                       rwkv_k_a[l], rwkv_r_k[l], rwkv_ln_g[l], rwkv_ln_b[l])
        if l == 0:
            v_first = v_vals
        b_c, b_l = gla_mixer(gl_c, gl_l, not last, gla_a2[l], gla_a_b[l], gla_norm_g[l])
        r_c, r_l = retention_mixer(rt_c, rt_l, not last, ret_decay[l], ret_norm_g[l])
        xl = xl + mod_l[2] * rms_norm(merge_branches((a_l, b_l, r_l), gate_l, w_branch[l], w_out[l]), norm_post_mix[l])

        h_l = modulate(rms_norm(xl, norm_pre_mlp[l]), mod_l[3], mod_l[4])
        xl = xl + mod_l[5] * rms_norm(squared_relu_mlp(h_l, mlp_w1[l], mlp_w2[l]), norm_post_mlp[l])
        if not last:
            xc = xc + mod_c[2] * rms_norm(merge_branches((a_c, b_c, r_c), gate_c, w_branch[l], w_out[l]), norm_post_mix[l])
            h_c = modulate(rms_norm(xc, norm_pre_mlp[l]), mod_c[3], mod_c[4])
            xc = xc + mod_c[5] * rms_norm(squared_relu_mlp(h_c, mlp_w1[l], mlp_w2[l]), norm_post_mlp[l])
    return xl
```

```cpp
#include <hip/hip_runtime.h>
#include <hip/hip_bf16.h>
#include <hip/hip_cooperative_groups.h>
#include <cstdio>
#include <cstdint>
#include <cstring>
namespace cg = cooperative_groups;

typedef unsigned short bfr;
using bf16x8 = __attribute__((ext_vector_type(8))) short;
using f32x4 = __attribute__((ext_vector_type(4))) float;
using u16x8 = __attribute__((ext_vector_type(8))) unsigned short;

constexpr int D = 1024, TC = 1024, TL = 16384, T = 17408, DEPTH = 4;
constexpr int NRW = 3584, NGLA = 3328, NRET = 4096, NGATE = 3072;
constexpr int D_IN = 13664;
constexpr int NTHR = 512;

enum { I_X = 0, I_C, I_CTX, I_CCTX, I_ADAW, I_ADAB, I_NPREMIX, I_NPOSTMIX, I_NPREMLP, I_NPOSTMLP, I_WIN, I_MU, I_W0,
       I_W2, I_A0, I_A2, I_G2, I_V0, I_V1, I_V2, I_KK, I_KA, I_RK, I_LNG, I_LNB, I_GA2, I_GAB, I_GNG, I_RDEC, I_RNG,
       I_WBR, I_WOUT, I_W1, I_W2M, N_IN };

constexpr size_t al256(size_t x) { return (x + 255) & ~size_t(255); }
constexpr size_t W_RW = 0;
constexpr size_t W_GLA = W_RW + (size_t)NRW * 1024;
constexpr size_t W_RET = W_GLA + (size_t)NGLA * 1024;
constexpr size_t W_GATE = W_RET + (size_t)NRET * 1024;
constexpr size_t W_BR = W_GATE + (size_t)NGATE * 1024;
constexpr size_t W_OUT = W_BR + (size_t)3 * 1024 * 1024;
constexpr size_t W_1 = W_OUT + (size_t)1024 * 1024;
constexpr size_t W_2 = W_1 + (size_t)4096 * 1024;
constexpr size_t W_L2F = W_2 + (size_t)4096 * 1024;
constexpr size_t W_L2B = W_L2F + 1024 * 64;
constexpr size_t W_LA2 = W_L2B + 1024 * 64;
constexpr size_t W_LG2 = W_LA2 + 1024 * 64;
constexpr size_t W_LV1 = W_LG2 + 1024 * 128;
constexpr size_t W_LV2 = W_LV1 + 128 * 1024;
constexpr size_t W_END = W_LV2 + 1024 * 64;

constexpr size_t SZ = (size_t)T * 1024 * 2;
constexpr size_t OFF_W = 0;
constexpr size_t OFF_XC = al256(W_END * 2);
constexpr size_t OFF_A = OFF_XC + (size_t)1024 * 1024 * 4;
constexpr size_t OFF_VF = OFF_A + SZ;
constexpr size_t OFF_MOD = OFF_VF + SZ;
constexpr size_t OFF_PRW = al256(OFF_MOD + (size_t)4 * 5 * 6144 * 4);
constexpr size_t OFF_PGLA = OFF_PRW + (size_t)T * NRW * 2;
constexpr size_t OFF_PRET = OFF_PGLA + (size_t)T * NGLA * 2;
constexpr size_t OFF_S7 = OFF_PRET + (size_t)T * NRET * 2;
constexpr size_t OFF_SM = OFF_S7 + 7 * SZ;
constexpr size_t OFF_U = OFF_SM + (size_t)T * 320 * 2;
constexpr size_t OFF_OGLA = OFF_U + (size_t)T * 128 * 2;
constexpr size_t OFF_ORET = OFF_OGLA + SZ;
constexpr size_t OFF_CUM = OFF_ORET + SZ;
constexpr size_t OFF_BAR = OFF_CUM + SZ;
constexpr size_t WS_NEED = OFF_BAR + 16384;
constexpr size_t OFF_OF = OFF_PRW, OFF_OB = OFF_PRW + SZ, OFF_G = OFF_PRW + 2 * SZ;
constexpr size_t OFF_MERGED = OFF_PGLA;
constexpr size_t OFF_Y = OFF_PRET;
constexpr size_t OFF_R = OFF_S7, OFF_KP = OFF_S7 + SZ, OFF_V = OFF_S7 + 2 * SZ, OFF_KKN = OFF_S7 + 3 * SZ,
                 OFF_AA = OFF_S7 + 4 * SZ, OFF_NEF = OFF_S7 + 5 * SZ, OFF_NEB = OFF_S7 + 6 * SZ;
constexpr size_t OFF_PGATE = OFF_S7 + 3 * SZ;
constexpr size_t OFF_H = OFF_S7;

constexpr int SMEM_BYTES = 147456 + 64;
#define SIMPLE_SCAN 0
#define REPEAT_MASK 0
#define ZERO_BRANCH 0


struct Pm {
  const float* in[N_IN];
  float* out;
  char* ws;
};

__device__ __forceinline__ bfr f2b(float f) {
  unsigned u = __float_as_uint(f);
  u += 0x7fffu + ((u >> 16) & 1u);
  return (bfr)(u >> 16);
}
__device__ __forceinline__ float b2f(bfr b) { return __uint_as_float(((unsigned)b) << 16); }
__device__ __forceinline__ float sigmoidf_(float x) { return 1.0f / (1.0f + __expf(-x)); }
__device__ __forceinline__ float siluf_(float x) { return x * sigmoidf_(x); }
__device__ __forceinline__ float wave_sum(float x) {
#pragma unroll
  for (int o = 32; o >= 1; o >>= 1) x += __shfl_xor(x, o);
  return x;
}
__device__ __forceinline__ int ftid() {
  int t = threadIdx.x;
  asm volatile("" : "+v"(t));
  return t;
}
#define WSP(T_, off) ((T_*)(P.ws + (off)))
#define WBF(off) ((bfr*)(P.ws + OFF_W) + (off))

__device__ __forceinline__ void conv_T(const float* __restrict__ src, int ld, int Ksrc, int Kdst, int nvalid, int npad, bfr* __restrict__ dst,
                       char* smem) {
  float* tile = (float*)smem;
  const int tid = ftid();
  const int nk = Kdst / 64, nn = npad / 64;
  for (int t = blockIdx.x; t < nk * nn; t += gridDim.x) {
    const int kt = t % nk, nt = t / nk;
    const int k0 = kt * 64, n0 = nt * 64;
#pragma unroll
    for (int i = 0; i < 2; i++) {
      const int e = tid + i * NTHR;
      const int kk = e >> 4, nq = (e & 15) * 4;
      float4 v = make_float4(0.f, 0.f, 0.f, 0.f);
      if (k0 + kk < Ksrc && n0 + nq < nvalid) v = *(const float4*)(src + (size_t)(k0 + kk) * ld + n0 + nq);
      float* tp = tile + kk * 65 + nq;
      tp[0] = v.x; tp[1] = v.y; tp[2] = v.z; tp[3] = v.w;
    }
    __syncthreads();
    {
      const int n = tid >> 3, kc = (tid & 7) * 8;
      u16x8 o;
#pragma unroll
      for (int i = 0; i < 8; i++) o[i] = f2b(tile[(kc + i) * 65 + n]);
      *(u16x8*)(dst + (size_t)(n0 + n) * Kdst + k0 + kc) = o;
    }
    __syncthreads();
  }
}

__device__ __forceinline__ void convert_layer(const Pm& P, int l, char* smem) {
  const float* win = P.in[I_WIN] + (size_t)l * 1024 * D_IN;
  conv_T(win + 0, D_IN, 1024, 1024, 3392, NRW, WBF(W_RW), smem);
  conv_T(win + 3392, D_IN, 1024, 1024, 3104, NGLA, WBF(W_GLA), smem);
  conv_T(win + 6496, D_IN, 1024, 1024, 4096, NRET, WBF(W_RET), smem);
  conv_T(win + 10592, D_IN, 1024, 1024, 3072, NGATE, WBF(W_GATE), smem);
  for (int i = 0; i < 3; i++)
    conv_T(P.in[I_WBR] + ((size_t)l * 3 + i) * 1024 * 1024, 1024, 1024, 1024, 1024, 1024, WBF(W_BR) + (size_t)i * 1024 * 1024,
           smem);
  conv_T(P.in[I_WOUT] + (size_t)l * 1024 * 1024, 1024, 1024, 1024, 1024, 1024, WBF(W_OUT), smem);
  conv_T(P.in[I_W1] + (size_t)l * 1024 * 4096, 4096, 1024, 1024, 4096, 4096, WBF(W_1), smem);
  conv_T(P.in[I_W2M] + (size_t)l * 4096 * 1024, 1024, 4096, 4096, 1024, 1024, WBF(W_2), smem);
  conv_T(P.in[I_W2] + ((size_t)l * 2 + 0) * 64 * 1024, 1024, 64, 64, 1024, 1024, WBF(W_L2F), smem);
  conv_T(P.in[I_W2] + ((size_t)l * 2 + 1) * 64 * 1024, 1024, 64, 64, 1024, 1024, WBF(W_L2B), smem);
  conv_T(P.in[I_A2] + (size_t)l * 64 * 1024, 1024, 64, 64, 1024, 1024, WBF(W_LA2), smem);
  conv_T(P.in[I_G2] + (size_t)l * 128 * 1024, 1024, 128, 128, 1024, 1024, WBF(W_LG2), smem);
  if (l > 0) {
    conv_T(P.in[I_V1] + (size_t)(l - 1) * 1024 * 32, 32, 1024, 1024, 32, 128, WBF(W_LV1), smem);
    conv_T(P.in[I_V2] + (size_t)(l - 1) * 32 * 1024, 1024, 32, 64, 1024, 1024, WBF(W_LV2), smem);
  }
}

__device__ __forceinline__ void phase_mod(const Pm& P, char* smem) {
  float* sc = (float*)smem;
  float* red = (float*)smem + 5 * 1024;
  const int tid = ftid();
  for (int e = tid; e < 5 * 1024; e += NTHR) {
    int r = e >> 10, k = e & 1023;
    float v = (r < 4) ? P.in[I_C][r * 1024 + k] : P.in[I_CCTX][k];
    sc[e] = siluf_(v);
  }
  __syncthreads();
  float* MODV = WSP(float, OFF_MOD);
  for (int item = blockIdx.x; item < 4 * 48; item += gridDim.x) {
    const int l = item / 48, cb = item % 48;
    const int col = cb * 128 + (tid & 127), kq = tid >> 7;
    const float* w = P.in[I_ADAW] + (size_t)l * 1024 * 6144 + col;
    float acc[5] = {0, 0, 0, 0, 0};
#pragma unroll 16
    for (int k = kq * 256; k < kq * 256 + 256; k++) {
      float wv = w[(size_t)k * 6144];
#pragma unroll
      for (int r = 0; r < 5; r++) acc[r] += sc[r * 1024 + k] * wv;
    }
#pragma unroll
    for (int r = 0; r < 5; r++) red[(kq * 5 + r) * 128 + (tid & 127)] = acc[r];
    __syncthreads();
    if (kq == 0) {
      float bias = P.in[I_ADAB][(size_t)l * 6144 + col];
#pragma unroll
      for (int r = 0; r < 5; r++) {
        float s = red[(0 * 5 + r) * 128 + tid] + red[(1 * 5 + r) * 128 + tid] + red[(2 * 5 + r) * 128 + tid] +
                  red[(3 * 5 + r) * 128 + tid];
        MODV[((size_t)l * 5 + r) * 6144 + col] = s + bias;
      }
    }
    __syncthreads();
  }
}

__device__ __forceinline__ void rowwise(const Pm& P, int mode, int l, int row_begin = 0) {
  const int tid_ = ftid();
  const int lane = tid_ & 63, wid = tid_ >> 6;
  const float* MODV = WSP(float, OFF_MOD);
  const float* Y = WSP(float, OFF_Y);
  bfr* A = WSP(bfr, OFF_A);
  for (int row = row_begin + blockIdx.x * 8 + wid; row < T; row += gridDim.x * 8) {
    float* xr = (row < TC) ? (WSP(float, OFF_XC) + (size_t)row * 1024) : (P.out + (size_t)(row - TC) * 1024);
    const int mrow = (row < TC) ? 4 : ((row - TC) >> 12);
    const float* md = MODV + ((size_t)l * 5 + mrow) * 6144;
    const int c0 = lane * 16;
    float x[16];
    const float* xsrc = xr;
    if (mode == 0) xsrc = (row < TC) ? (P.in[I_CTX] + (size_t)row * 1024) : (P.in[I_X] + (size_t)(row - TC) * 1024);
#pragma unroll
    for (int i = 0; i < 4; i++) {
      float4 v = *(const float4*)(xsrc + c0 + i * 4);
      x[i * 4 + 0] = v.x; x[i * 4 + 1] = v.y; x[i * 4 + 2] = v.z; x[i * 4 + 3] = v.w;
    }
    if (mode != 0) {
      float y[16];
      float ss = 0.f;
#pragma unroll
      for (int i = 0; i < 4; i++) {
        float4 v = *(const float4*)(Y + (size_t)row * 1024 + c0 + i * 4);
        y[i * 4 + 0] = v.x; y[i * 4 + 1] = v.y; y[i * 4 + 2] = v.z; y[i * 4 + 3] = v.w;
      }
#pragma unroll
      for (int i = 0; i < 16; i++) ss += y[i] * y[i];
      ss = wave_sum(ss);
      const float rs = rsqrtf(ss * (1.0f / 1024.0f) + 1e-6f);
      const float* gate = md + (mode == 1 ? 2 : 5) * 1024 + c0;
      const float* gp = P.in[mode == 1 ? I_NPOSTMIX : I_NPOSTMLP] + (size_t)l * 1024 + c0;
#pragma unroll
      for (int i = 0; i < 16; i++) x[i] += gate[i] * (y[i] * rs * gp[i]);
    }
    if (mode != 2 || true) {
#pragma unroll
      for (int i = 0; i < 4; i++) *(float4*)(xr + c0 + i * 4) = make_float4(x[i * 4], x[i * 4 + 1], x[i * 4 + 2], x[i * 4 + 3]);
    }
    if (mode == 2 && l + 1 >= DEPTH) continue;
    float ss2 = 0.f;
#pragma unroll
    for (int i = 0; i < 16; i++) ss2 += x[i] * x[i];
    ss2 = wave_sum(ss2);
    const float rs2 = rsqrtf(ss2 * (1.0f / 1024.0f) + 1e-6f);
    const float *gpre, *shift, *scale;
    if (mode == 0) {
      gpre = P.in[I_NPREMIX] + c0; shift = md + c0; scale = md + 1024 + c0;
    } else if (mode == 1) {
      gpre = P.in[I_NPREMLP] + (size_t)l * 1024 + c0; shift = md + 3 * 1024 + c0; scale = md + 4 * 1024 + c0;
    } else {
      const float* md2 = MODV + ((size_t)(l + 1) * 5 + mrow) * 6144;
      gpre = P.in[I_NPREMIX] + (size_t)(l + 1) * 1024 + c0; shift = md2 + c0; scale = md2 + 1024 + c0;
    }
    u16x8 o0, o1;
#pragma unroll
    for (int i = 0; i < 8; i++) {
      o0[i] = f2b((x[i] * rs2 * gpre[i]) * (1.0f + scale[i]) + shift[i]);
      o1[i] = f2b((x[i + 8] * rs2 * gpre[i + 8]) * (1.0f + scale[i + 8]) + shift[i + 8]);
    }
    *(u16x8*)(A + (size_t)row * 1024 + c0) = o0;
    *(u16x8*)(A + (size_t)row * 1024 + c0 + 8) = o1;
  }
}

constexpr int STAGE_BYTES = 49152;
__device__ __forceinline__ void gemm_stage(const bfr* __restrict__ A, int lda, const bfr* __restrict__ Bt, int ldb, int row0,
                                           int col0, int k0, char* st, int tid) {
#pragma unroll
  for (int s = 0; s < 2; s++) {
#pragma unroll
    for (int i = 0; i < 2; i++) {
      int c = tid + i * NTHR;
      int r = c >> 2, kc = (((c & 3) ^ ((0x1320 >> (r & 12)) & 3))) * 8;
      __builtin_amdgcn_global_load_lds((const unsigned*)(A + (size_t)(row0 + r) * lda + k0 + s * 32 + kc),
                                       (unsigned*)(st + s * 16384 + c * 16), 16, 0, 0);
    }
    {
      int c = tid;
      int r = c >> 2, kc = (((c & 3) ^ ((0x1320 >> (r & 12)) & 3))) * 8;
      __builtin_amdgcn_global_load_lds((const unsigned*)(Bt + (size_t)(col0 + r) * ldb + k0 + s * 32 + kc),
                                       (unsigned*)(st + 32768 + s * 8192 + c * 16), 16, 0, 0);
    }
  }
}
struct Frags { bf16x8 a[2][4], b[2][4]; };
__device__ __forceinline__ void gemm_load_frags(const char* st, Frags& f, int wr, int wc, int fr, int fq) {
  const int fqs = fq ^ ((0x1320 >> (fr & 12)) & 3);
#pragma unroll
  for (int s = 0; s < 2; s++) {
#pragma unroll
    for (int m = 0; m < 4; m++) f.a[s][m] = *(const bf16x8*)(st + s * 16384 + ((wr * 64 + m * 16 + fr) * 32 + fqs * 8) * 2);
#pragma unroll
    for (int n = 0; n < 4; n++) f.b[s][n] = *(const bf16x8*)(st + 32768 + s * 8192 + ((wc * 64 + n * 16 + fr) * 32 + fqs * 8) * 2);
  }
}
__device__ __forceinline__ void gemm_mfma(const Frags& f, f32x4 (&acc)[4][4]) {
#pragma unroll
  for (int s = 0; s < 2; s++) {
#pragma unroll
    for (int m = 0; m < 4; m++)
#pragma unroll
      for (int n = 0; n < 4; n++) acc[m][n] = __builtin_amdgcn_mfma_f32_16x16x32_bf16(f.a[s][m], f.b[s][n], acc[m][n], 0, 0, 0);
  }
}
__device__ __forceinline__ void gemm_kloop(const bfr* __restrict__ A, int lda, const bfr* __restrict__ Bt, int ldb, int row0,
                                           int col0, int K, char* smem, f32x4 (&acc)[4][4], int tid, bool pre) {
  const int wid = tid >> 6, lane = tid & 63;
  const int wr = wid >> 1, wc = wid & 1, fr = lane & 15, fq = lane >> 4;
  const int nk = K >> 6;
  const bool grpY = wid >= 4;
  if (!pre) {
    gemm_stage(A, lda, Bt, ldb, row0, col0, 0, smem, tid);
    if (nk > 1) gemm_stage(A, lda, Bt, ldb, row0, col0, 64, smem + STAGE_BYTES, tid);
  }
  Frags F;
#pragma unroll
  for (int s = 0; s < 2; s++)
#pragma unroll
    for (int m = 0; m < 4; m++) { F.a[s][m] = bf16x8{0, 0, 0, 0, 0, 0, 0, 0}; F.b[s][m] = bf16x8{0, 0, 0, 0, 0, 0, 0, 0}; }
  int cur = 0, nxt = 2;
  for (int kt = 0; kt < nk; kt++) {
    if (kt + 1 < nk) asm volatile("s_waitcnt vmcnt(6)" ::: "memory");
    else asm volatile("s_waitcnt vmcnt(0)" ::: "memory");
    __syncthreads();
    if (kt + 2 < nk) gemm_stage(A, lda, Bt, ldb, row0, col0, (kt + 2) * 64, smem + nxt * STAGE_BYTES, tid);
    if (grpY) gemm_mfma(F, acc);
    __builtin_amdgcn_sched_barrier(0);
    gemm_load_frags(smem + cur * STAGE_BYTES, F, wr, wc, fr, fq);
    __builtin_amdgcn_sched_barrier(0);
    if (!grpY) gemm_mfma(F, acc);
    cur = (cur == 2) ? 0 : cur + 1;
    nxt = (nxt == 2) ? 0 : nxt + 1;
  }
  if (grpY) gemm_mfma(F, acc);
  __syncthreads();
}
__device__ __forceinline__ void tile_map(int tile, int nM, int nN, int& mt, int& nt) {
  const int WGM = 16;
  int nig = WGM * nN, gid = tile / nig, fm = gid * WGM;
  int gs = min(nM - fm, WGM);
  mt = fm + (tile % nig) % gs;
  nt = (tile % nig) / gs;
}

template <class Epi>
__device__ __forceinline__ void gemm_phase(const bfr* A, int lda, const bfr* Bt, int ldb, int M, int N, int K, const Epi& epi, char* smem,
                           int tile_off, int tile_total) {
  const int nM = M >> 8, nN = N >> 7;
  const int tid = ftid(), wid = tid >> 6, lane = tid & 63;
  const int wr = wid >> 1, wc = wid & 1, fr = lane & 15, fq = lane >> 4;
  int first = blockIdx.x;
  int g0 = tile_off;
  int start = ((first - (g0 % (int)gridDim.x)) % (int)gridDim.x + (int)gridDim.x) % (int)gridDim.x;
  bool pre = false;
  for (int tile = start; tile < nM * nN; tile += gridDim.x) {
    int mt, nt;
    tile_map(tile, nM, nN, mt, nt);
    f32x4 acc[4][4];
#pragma unroll
    for (int m = 0; m < 4; m++)
#pragma unroll
      for (int n = 0; n < 4; n++) acc[m][n] = f32x4{0.f, 0.f, 0.f, 0.f};
    gemm_kloop(A, lda, Bt, ldb, mt * 256, nt * 128, K, smem, acc, tid, pre);
    pre = false;
    if (tile + (int)gridDim.x < nM * nN) {
      int mt2, nt2;
      tile_map(tile + (int)gridDim.x, nM, nN, mt2, nt2);
      gemm_stage(A, lda, Bt, ldb, mt2 * 256, nt2 * 128, 0, smem, tid);
      if (K > 64) gemm_stage(A, lda, Bt, ldb, mt2 * 256, nt2 * 128, 64, smem + STAGE_BYTES, tid);
      pre = true;
    }
    epi(acc, mt * 256 + wr * 64, nt * 128 + wc * 64, fr, fq);
  }
  (void)tile_total;
}

template <class F>
__device__ __forceinline__ void wave_store_bf16(f32x4 (&acc)[4][4], const F& f, bfr* C, int ldc, int rb, int cb, int fr, int fq,
                                                char* sm) {
  const int tid_ = threadIdx.x;
  const int lane = tid_ & 63;
  bfr* sc = (bfr*)(sm + 2 * STAGE_BYTES + (tid_ >> 6) * 6144);
#pragma unroll
  for (int half = 0; half < 2; half++) {
#pragma unroll
    for (int mm = 0; mm < 2; mm++)
#pragma unroll
      for (int n = 0; n < 4; n++)
#pragma unroll
        for (int j = 0; j < 4; j++)
          sc[(mm * 16 + fq * 4 + j) * 72 + n * 16 + fr] = f2b(f(acc[half * 2 + mm][n][j], cb + n * 16 + fr));
    __builtin_amdgcn_fence(__ATOMIC_RELEASE, "wavefront");
    __builtin_amdgcn_wave_barrier();
    __builtin_amdgcn_fence(__ATOMIC_ACQUIRE, "wavefront");
#pragma unroll
    for (int it = 0; it < 4; it++) {
      const int id = it * 64 + lane;
      const int rl = id >> 3, ch = id & 7;
      u16x8 v = *(const u16x8*)(sc + rl * 72 + ch * 8);
      *(u16x8*)(C + (size_t)(rb + half * 32 + rl) * ldc + cb + ch * 8) = v;
    }
    __builtin_amdgcn_fence(__ATOMIC_RELEASE, "wavefront");
    __builtin_amdgcn_wave_barrier();
    __builtin_amdgcn_fence(__ATOMIC_ACQUIRE, "wavefront");
  }
}
struct EpiBf16 {
  bfr* C; int ldc; char* sm;
  __device__ __forceinline__ void operator()(f32x4 (&acc)[4][4], int rb, int cb, int fr, int fq) const {
    wave_store_bf16(acc, [](float v, int) { return v; }, C, ldc, rb, cb, fr, fq, sm);
  }
};
struct EpiIn {
  char* ws; char* sm;
  __device__ __forceinline__ void operator()(f32x4 (&acc)[4][4], int rb, int cb, int fr, int fq) const {
    const int seg = (cb >= NRW) + (cb >= NRW + NGLA);
    const size_t off = (seg == 0) ? OFF_PRW : ((seg == 1) ? OFF_PGLA : OFF_PRET);
    const int ldc = (seg == 0) ? NRW : ((seg == 1) ? NGLA : NRET);
    const int c0 = cb - ((seg == 0) ? 0 : ((seg == 1) ? NRW : NRW + NGLA));
    wave_store_bf16(acc, [](float v, int) { return v; }, (bfr*)(ws + off), ldc, rb, c0, fr, fq, sm);
  }
};
struct EpiF32 {
  float* C; int ldc;
  __device__ __forceinline__ void operator()(f32x4 (&acc)[4][4], int rb, int cb, int fr, int fq) const {
#pragma unroll
    for (int m = 0; m < 4; m++)
#pragma unroll
      for (int n = 0; n < 4; n++)
#pragma unroll
        for (int j = 0; j < 4; j++) C[(size_t)(rb + m * 16 + fq * 4 + j) * ldc + cb + n * 16 + fr] = acc[m][n][j];
  }
};
struct EpiRelu2 {
  bfr* C; int ldc; char* sm;
  __device__ __forceinline__ void operator()(f32x4 (&acc)[4][4], int rb, int cb, int fr, int fq) const {
    wave_store_bf16(acc, [](float v, int) { float r = fmaxf(v, 0.f); return r * r; }, C, ldc, rb, cb, fr, fq, sm);
  }
};
struct EpiSigmoid {
  bfr* C; int ldc; char* sm;
  __device__ __forceinline__ void operator()(f32x4 (&acc)[4][4], int rb, int cb, int fr, int fq) const {
    wave_store_bf16(acc, [](float v, int) { return sigmoidf_(v); }, C, ldc, rb, cb, fr, fq, sm);
  }
};
struct EpiDecay {
  const float* w0; bfr* C; char* sm;
  __device__ __forceinline__ void operator()(f32x4 (&acc)[4][4], int rb, int cb, int fr, int fq) const {
    const float* w0_ = w0;
    wave_store_bf16(acc, [w0_](float v, int col) {
      float x = w0_[col] + v;
      float lw = -0.6065306597126334f * sigmoidf_(x);
      return __expf(lw) - 1.0f;
    }, C, 1024, rb, cb, fr, fq, sm);
  }
};
struct EpiA {
  const float *a0, *k_k, *k_a;
  bfr *KP, *KKN, *AA;
  __device__ __forceinline__ void operator()(f32x4 (&acc)[4][4], int rb, int cb, int fr, int fq) const {
    float a0c[4], kkc[4], kac[4];
#pragma unroll
    for (int n = 0; n < 4; n++) {
      int col = cb + n * 16 + fr;
      a0c[n] = a0[col]; kkc[n] = k_k[col]; kac[n] = k_a[col];
    }
#pragma unroll
    for (int m = 0; m < 4; m++)
#pragma unroll
      for (int j = 0; j < 4; j++) {
        const size_t rowoff = (size_t)(rb + m * 16 + fq * 4 + j) * 1024;
        float k0[4], kr[4], av[4];
        float ss = 0.f;
#pragma unroll
        for (int n = 0; n < 4; n++) {
          int col = cb + n * 16 + fr;
          k0[n] = b2f(KP[rowoff + col]);
          kr[n] = k0[n] * kkc[n];
          ss += kr[n] * kr[n];
          av[n] = sigmoidf_(a0c[n] + acc[m][n][j]);
        }
        ss += __shfl_xor(ss, 1); ss += __shfl_xor(ss, 2); ss += __shfl_xor(ss, 4); ss += __shfl_xor(ss, 8);
        const float rn = rsqrtf(fmaxf(ss, 1e-12f));
#pragma unroll
        for (int n = 0; n < 4; n++) {
          int col = cb + n * 16 + fr;
          KKN[rowoff + col] = f2b(kr[n] * rn);
          AA[rowoff + col] = f2b(-(kr[n] * rn) * av[n]);
          KP[rowoff + col] = f2b(k0[n] * (1.0f + (av[n] - 1.0f) * kac[n]));
        }
      }
  }
};
struct EpiVres {
  const float* v0b; bfr* V; const bfr* VF;
  __device__ __forceinline__ void operator()(f32x4 (&acc)[4][4], int rb, int cb, int fr, int fq) const {
#pragma unroll
    for (int n = 0; n < 4; n++) {
      const int col = cb + n * 16 + fr;
      const float bc = v0b[col];
#pragma unroll
      for (int m = 0; m < 4; m++)
#pragma unroll
        for (int j = 0; j < 4; j++) {
          size_t idx = (size_t)(rb + m * 16 + fq * 4 + j) * 1024 + col;
          float v0 = b2f(V[idx]), vf = b2f(VF[idx]);
          V[idx] = f2b(v0 + (vf - v0) * sigmoidf_(bc + acc[m][n][j]));
        }
    }
  }
};

struct EpiBranch {
  const bfr* PG; bfr* MG; int i;
  __device__ __forceinline__ void operator()(f32x4 (&acc)[4][4], int rb, int cb, int fr, int fq) const {
#pragma unroll
    for (int n = 0; n < 4; n++) {
      const int col = cb + n * 16 + fr;
#pragma unroll
      for (int m = 0; m < 4; m++)
#pragma unroll
        for (int j = 0; j < 4; j++) {
          const size_t r_ = (size_t)(rb + m * 16 + fq * 4 + j);
          float v = b2f(PG[r_ * NGATE + i * 1024 + col]) * acc[m][n][j];
          if (i > 0) v += b2f(MG[r_ * 1024 + col]);
          MG[r_ * 1024 + col] = f2b(v);
        }
    }
  }
};

__device__ __forceinline__ void rwkv_lerp(const Pm& P, int l) {
  const bfr* PR = WSP(bfr, OFF_PRW);
  const float* mu = P.in[I_MU] + (size_t)l * 3392;
  bfr* R = WSP(bfr, OFF_R); bfr* KP = WSP(bfr, OFF_KP); bfr* V = WSP(bfr, OFF_V); bfr* VF = WSP(bfr, OFF_VF);
  bfr* SM = WSP(bfr, OFF_SM);
  const long nitems = (long)T * 424;
  for (long it = (long)blockIdx.x * NTHR + ftid(); it < nitems; it += (long)gridDim.x * NTHR) {
    const int row = (int)(it / 424), j = (int)(it % 424);
    const int c0 = j * 8;
    const bfr* pr = PR + (size_t)row * NRW + c0;
    u16x8 p = *(const u16x8*)pr;
    u16x8 nb[4];
    const u16x8 zero = {0, 0, 0, 0, 0, 0, 0, 0};
    if (row < TC) {
      const int t = row & 255;
      nb[0] = (t > 0) ? *(const u16x8*)(pr - NRW) : zero;
      nb[1] = (t < 255) ? *(const u16x8*)(pr + NRW) : zero;
      nb[2] = nb[0]; nb[3] = nb[1];
    } else {
      const int t = (row - TC) & 4095;
      const int gx = t & 63, gy = t >> 6;
      nb[0] = (gx > 0) ? *(const u16x8*)(pr - NRW) : zero;
      nb[1] = (gx < 63) ? *(const u16x8*)(pr + NRW) : zero;
      nb[2] = (gy > 0) ? *(const u16x8*)(pr - (size_t)64 * NRW) : zero;
      nb[3] = (gy < 63) ? *(const u16x8*)(pr + (size_t)64 * NRW) : zero;
    }
    float o[8];
#pragma unroll
    for (int e = 0; e < 8; e++) {
      float pv = b2f(p[e]);
      float sv = b2f(nb[e & 3][e]);
      o[e] = pv + (sv - pv) * mu[c0 + e];
    }
    u16x8 ov;
    if (c0 < 3072) {
#pragma unroll
      for (int e = 0; e < 8; e++) ov[e] = f2b(o[e]);
      const int seg = c0 >> 10, cc = c0 & 1023;
      bfr* dst = (seg == 0) ? R : (seg == 1 ? KP : V);
      *(u16x8*)(dst + (size_t)row * 1024 + cc) = ov;
      if (seg == 2 && l == 0) *(u16x8*)(VF + (size_t)row * 1024 + cc) = ov;
    } else {
      const int cs = c0 - 3072;
#pragma unroll
      for (int e = 0; e < 8; e++) {
        float v = o[e];
        if (cs < 128) v = tanhf(v);
        else if (cs >= 192) v = sigmoidf_(v);
        ov[e] = f2b(v);
      }
      *(u16x8*)(SM + (size_t)row * 320 + cs) = ov;
    }
  }
}

__device__ __forceinline__ void ret_prep(const Pm& P) {
  bfr* PT = WSP(bfr, OFF_PRET);
  const long nitems = (long)T * 64;
  for (long it = (long)blockIdx.x * NTHR + ftid(); it < nitems; it += (long)gridDim.x * NTHR) {
    const int row = (int)(it >> 6), rem = (int)(it & 63);
    const int h = rem >> 4, i0 = (rem & 15) * 8;
    const float pos = (row < TC) ? (float)(row & 255) : (float)(256 + ((row - TC) & 4095));
    float cs[8], sn[8];
#pragma unroll
    for (int e = 0; e < 8; e++) {
      float invf = powf(10000.0f, -(float)(i0 + e) * (1.0f / 128.0f));
      float ang = pos * invf;
      sincosf(ang, &sn[e], &cs[e]);
    }
#pragma unroll
    for (int qk = 0; qk < 2; qk++) {
      bfr* base = PT + (size_t)row * NRET + qk * 1024 + h * 256 + i0;
      u16x8 t1 = *(u16x8*)base, t2 = *(u16x8*)(base + 128);
      const float scl = qk ? 0.0625f : 1.0f;
      u16x8 o1, o2;
#pragma unroll
      for (int e = 0; e < 8; e++) {
        float a = b2f(t1[e]), b = b2f(t2[e]);
        o1[e] = f2b((a * cs[e] - b * sn[e]) * scl);
        o2[e] = f2b((a * sn[e] + b * cs[e]) * scl);
      }
      *(u16x8*)base = o1;
      *(u16x8*)(base + 128) = o2;
    }
  }
}

#define FMAC_BC(acc, x, s, J) \
  asm("v_fmac_f32_dpp %0, %1, %2 row_newbcast:" #J " row_mask:0xf bank_mask:0xf" : "+v"(acc) : "v"(x), "v"(s))
#define DOT16(o0_, o1_, o2_, o3_, x_) asm("v_mul_f32_dpp %0, %4, %5 row_newbcast:0 row_mask:0xf bank_mask:0xf\n\t" \
  "v_mul_f32_dpp %1, %4, %6 row_newbcast:1 row_mask:0xf bank_mask:0xf\n\t" \
  "v_mul_f32_dpp %2, %4, %7 row_newbcast:2 row_mask:0xf bank_mask:0xf\n\t" \
  "v_mul_f32_dpp %3, %4, %8 row_newbcast:3 row_mask:0xf bank_mask:0xf\n\t" \
  "v_fmac_f32_dpp %0, %4, %9 row_newbcast:4 row_mask:0xf bank_mask:0xf\n\t" \
  "v_fmac_f32_dpp %1, %4, %10 row_newbcast:5 row_mask:0xf bank_mask:0xf\n\t" \
  "v_fmac_f32_dpp %2, %4, %11 row_newbcast:6 row_mask:0xf bank_mask:0xf\n\t" \
  "v_fmac_f32_dpp %3, %4, %12 row_newbcast:7 row_mask:0xf bank_mask:0xf\n\t" \
  "v_fmac_f32_dpp %0, %4, %13 row_newbcast:8 row_mask:0xf bank_mask:0xf\n\t" \
  "v_fmac_f32_dpp %1, %4, %14 row_newbcast:9 row_mask:0xf bank_mask:0xf\n\t" \
  "v_fmac_f32_dpp %2, %4, %15 row_newbcast:10 row_mask:0xf bank_mask:0xf\n\t" \
  "v_fmac_f32_dpp %3, %4, %16 row_newbcast:11 row_mask:0xf bank_mask:0xf\n\t" \
  "v_fmac_f32_dpp %0, %4, %17 row_newbcast:12 row_mask:0xf bank_mask:0xf\n\t" \
  "v_fmac_f32_dpp %1, %4, %18 row_newbcast:13 row_mask:0xf bank_mask:0xf\n\t" \
  "v_fmac_f32_dpp %2, %4, %19 row_newbcast:14 row_mask:0xf bank_mask:0xf\n\t" \
  "v_fmac_f32_dpp %3, %4, %20 row_newbcast:15 row_mask:0xf bank_mask:0xf\n\t" \
  : "=&v"(o0_), "=&v"(o1_), "=&v"(o2_), "=&v"(o3_) \
  : "v"(x_), "v"(S[0]), "v"(S[1]), "v"(S[2]), "v"(S[3]), "v"(S[4]), "v"(S[5]), "v"(S[6]), "v"(S[7]), "v"(S[8]), "v"(S[9]), "v"(S[10]), "v"(S[11]), "v"(S[12]), "v"(S[13]), "v"(S[14]), "v"(S[15]))
#define UPD_A(ne_, kp_, vv_) asm("v_fmac_f32_dpp %0, %16, %0 row_newbcast:0 row_mask:0xf bank_mask:0xf\n\t" \
  "v_fmac_f32_dpp %1, %16, %1 row_newbcast:1 row_mask:0xf bank_mask:0xf\n\t" \
  "v_fmac_f32_dpp %2, %16, %2 row_newbcast:2 row_mask:0xf bank_mask:0xf\n\t" \
  "v_fmac_f32_dpp %3, %16, %3 row_newbcast:3 row_mask:0xf bank_mask:0xf\n\t" \
  "v_fmac_f32_dpp %4, %16, %4 row_newbcast:4 row_mask:0xf bank_mask:0xf\n\t" \
  "v_fmac_f32_dpp %5, %16, %5 row_newbcast:5 row_mask:0xf bank_mask:0xf\n\t" \
  "v_fmac_f32_dpp %6, %16, %6 row_newbcast:6 row_mask:0xf bank_mask:0xf\n\t" \
  "v_fmac_f32_dpp %7, %16, %7 row_newbcast:7 row_mask:0xf bank_mask:0xf\n\t" \
  "v_fmac_f32_dpp %8, %16, %8 row_newbcast:8 row_mask:0xf bank_mask:0xf\n\t" \
  "v_fmac_f32_dpp %9, %16, %9 row_newbcast:9 row_mask:0xf bank_mask:0xf\n\t" \
  "v_fmac_f32_dpp %10, %16, %10 row_newbcast:10 row_mask:0xf bank_mask:0xf\n\t" \
  "v_fmac_f32_dpp %11, %16, %11 row_newbcast:11 row_mask:0xf bank_mask:0xf\n\t" \
  "v_fmac_f32_dpp %12, %16, %12 row_newbcast:12 row_mask:0xf bank_mask:0xf\n\t" \
  "v_fmac_f32_dpp %13, %16, %13 row_newbcast:13 row_mask:0xf bank_mask:0xf\n\t" \
  "v_fmac_f32_dpp %14, %16, %14 row_newbcast:14 row_mask:0xf bank_mask:0xf\n\t" \
  "v_fmac_f32_dpp %15, %16, %15 row_newbcast:15 row_mask:0xf bank_mask:0xf\n\t" \
  "v_fmac_f32_dpp %0, %17, %18 row_newbcast:0 row_mask:0xf bank_mask:0xf\n\t" \
  "v_fmac_f32_dpp %1, %17, %18 row_newbcast:1 row_mask:0xf bank_mask:0xf\n\t" \
  "v_fmac_f32_dpp %2, %17, %18 row_newbcast:2 row_mask:0xf bank_mask:0xf\n\t" \
  "v_fmac_f32_dpp %3, %17, %18 row_newbcast:3 row_mask:0xf bank_mask:0xf\n\t" \
  "v_fmac_f32_dpp %4, %17, %18 row_newbcast:4 row_mask:0xf bank_mask:0xf\n\t" \
  "v_fmac_f32_dpp %5, %17, %18 row_newbcast:5 row_mask:0xf bank_mask:0xf\n\t" \
  "v_fmac_f32_dpp %6, %17, %18 row_newbcast:6 row_mask:0xf bank_mask:0xf\n\t" \
  "v_fmac_f32_dpp %7, %17, %18 row_newbcast:7 row_mask:0xf bank_mask:0xf\n\t" \
  "v_fmac_f32_dpp %8, %17, %18 row_newbcast:8 row_mask:0xf bank_mask:0xf\n\t" \
  "v_fmac_f32_dpp %9, %17, %18 row_newbcast:9 row_mask:0xf bank_mask:0xf\n\t" \
  "v_fmac_f32_dpp %10, %17, %18 row_newbcast:10 row_mask:0xf bank_mask:0xf\n\t" \
  "v_fmac_f32_dpp %11, %17, %18 row_newbcast:11 row_mask:0xf bank_mask:0xf\n\t" \
  "v_fmac_f32_dpp %12, %17, %18 row_newbcast:12 row_mask:0xf bank_mask:0xf\n\t" \
  "v_fmac_f32_dpp %13, %17, %18 row_newbcast:13 row_mask:0xf bank_mask:0xf\n\t" \
  "v_fmac_f32_dpp %14, %17, %18 row_newbcast:14 row_mask:0xf bank_mask:0xf\n\t" \
  "v_fmac_f32_dpp %15, %17, %18 row_newbcast:15 row_mask:0xf bank_mask:0xf\n\t" \
  : "+v"(S[0]), "+v"(S[1]), "+v"(S[2]), "+v"(S[3]), "+v"(S[4]), "+v"(S[5]), "+v"(S[6]), "+v"(S[7]), "+v"(S[8]), "+v"(S[9]), "+v"(S[10]), "+v"(S[11]), "+v"(S[12]), "+v"(S[13]), "+v"(S[14]), "+v"(S[15]) \
  : "v"(ne_), "v"(kp_), "v"(vv_))
#define UPD_B(nkka_, sa_) asm("v_fmac_f32_dpp %0, %16, %17 row_newbcast:0 row_mask:0xf bank_mask:0xf\n\t" \
  "v_fmac_f32_dpp %1, %16, %17 row_newbcast:1 row_mask:0xf bank_mask:0xf\n\t" \
  "v_fmac_f32_dpp %2, %16, %17 row_newbcast:2 row_mask:0xf bank_mask:0xf\n\t" \
  "v_fmac_f32_dpp %3, %16, %17 row_newbcast:3 row_mask:0xf bank_mask:0xf\n\t" \
  "v_fmac_f32_dpp %4, %16, %17 row_newbcast:4 row_mask:0xf bank_mask:0xf\n\t" \
  "v_fmac_f32_dpp %5, %16, %17 row_newbcast:5 row_mask:0xf bank_mask:0xf\n\t" \
  "v_fmac_f32_dpp %6, %16, %17 row_newbcast:6 row_mask:0xf bank_mask:0xf\n\t" \
  "v_fmac_f32_dpp %7, %16, %17 row_newbcast:7 row_mask:0xf bank_mask:0xf\n\t" \
  "v_fmac_f32_dpp %8, %16, %17 row_newbcast:8 row_mask:0xf bank_mask:0xf\n\t" \
  "v_fmac_f32_dpp %9, %16, %17 row_newbcast:9 row_mask:0xf bank_mask:0xf\n\t" \
  "v_fmac_f32_dpp %10, %16, %17 row_newbcast:10 row_mask:0xf bank_mask:0xf\n\t" \
  "v_fmac_f32_dpp %11, %16, %17 row_newbcast:11 row_mask:0xf bank_mask:0xf\n\t" \
  "v_fmac_f32_dpp %12, %16, %17 row_newbcast:12 row_mask:0xf bank_mask:0xf\n\t" \
  "v_fmac_f32_dpp %13, %16, %17 row_newbcast:13 row_mask:0xf bank_mask:0xf\n\t" \
  "v_fmac_f32_dpp %14, %16, %17 row_newbcast:14 row_mask:0xf bank_mask:0xf\n\t" \
  "v_fmac_f32_dpp %15, %16, %17 row_newbcast:15 row_mask:0xf bank_mask:0xf\n\t" \
  : "+v"(S[0]), "+v"(S[1]), "+v"(S[2]), "+v"(S[3]), "+v"(S[4]), "+v"(S[5]), "+v"(S[6]), "+v"(S[7]), "+v"(S[8]), "+v"(S[9]), "+v"(S[10]), "+v"(S[11]), "+v"(S[12]), "+v"(S[13]), "+v"(S[14]), "+v"(S[15]) \
  : "v"(nkka_), "v"(sa_))
#define REP16(M) M(0) M(1) M(2) M(3) M(4) M(5) M(6) M(7) M(8) M(9) M(10) M(11) M(12) M(13) M(14) M(15)
__device__ __forceinline__ float rowsum4(float x) {
  float a = x, b = x;
  asm volatile("s_nop 1\n\tv_permlane32_swap_b32 %0, %1" : "+v"(a), "+v"(b));
  float s = a + b;
  float c = s, d = s;
  asm volatile("s_nop 1\n\tv_permlane16_swap_b32 %0, %1" : "+v"(c), "+v"(d));
  return c + d;
}
__device__ __forceinline__ int seq_row(int p, int b, int dir) {
  if (p < 256) return b * 256 + (dir ? 255 - p : p);
  int q = p - 256;
  return TC + b * 4096 + (dir ? 4095 - q : q);
}
__device__ __forceinline__ void rwkv_scan(const Pm& P, int unit, char* smem) {
  const int tid = ftid(), wid = tid >> 6, lane = tid & 63;
  const int b = unit >> 5, h = (unit >> 1) & 15, dir = unit & 1;
  const bfr* S7b = WSP(bfr, OFF_S7);
  bfr* O = dir ? WSP(bfr, OFF_OB) : WSP(bfr, OFF_OF);
  constexpr int CHB = 64 * 6 * 64 * 2;
  const int colv = h * 64 + (wid & 3) * 16 + (lane & 15);
  float S[16];
#pragma unroll
  for (int j = 0; j < 16; j++) S[j] = 0.f;
  const int lt = tid - 256;
  auto load_chunk = [&](int c, char* buf) {
#pragma unroll
    for (int i = 0; i < 12; i++) {
      const int idx = lt + 256 * i;
      const int step = idx / 48, rem = idx - step * 48;
      const int arr = rem >> 3, part = rem & 7;
      const int am = (arr == 0) ? 0 : (arr == 1) ? 1 : (arr == 2) ? 3 : (arr == 3) ? 4 : (arr == 4) ? (5 + dir) : 2;
      const bfr* src = S7b + (size_t)am * ((size_t)T * 1024) + (size_t)seq_row(c * 64 + step, b, dir) * 1024 + h * 64 + part * 8;
      __builtin_amdgcn_global_load_lds((const unsigned*)src, (unsigned*)(buf + idx * 16), 16, 0, 0);
    }
  };
  __syncthreads();
  if (wid >= 4) {
    load_chunk(0, smem);
    asm volatile("s_waitcnt vmcnt(0)" ::: "memory");
  }
  __syncthreads();
  for (int c = 0; c < 68; c++) {
    if (wid >= 4) {
      if (c + 1 < 68) load_chunk(c + 1, smem + ((c + 1) & 1) * CHB);
      asm volatile("s_waitcnt vmcnt(0)" ::: "memory");
    } else {
      const bfr* buf = (const bfr*)(smem + (c & 1) * CHB);
      const int q_ = lane >> 4;
      const int rbase_c = seq_row(c * 64, b, dir);
      const int sgn = dir ? -1 : 1;
      bfr* Oq = O + (size_t)(rbase_c + sgn * q_) * 1024 + colv;
      auto ld = [&](int s, bfr (&x)[6]) {
        const bfr* sp = buf + s * 384;
        x[0] = sp[lane]; x[1] = sp[64 + lane]; x[2] = sp[128 + lane]; x[3] = sp[192 + lane]; x[4] = sp[256 + lane];
        x[5] = sp[320 + wid * 16 + (lane & 15)];
      };
      auto group = [&](bfr (&X)[4][6], int s) {
        float op[4];
#pragma unroll
        for (int u = 0; u < 4; u++) {
          float r = b2f(X[u][0]), kp = b2f(X[u][1]), kk = b2f(X[u][2]), nkka = b2f(X[u][3]), ne = b2f(X[u][4]), vv = b2f(X[u][5]);
          asm volatile("s_nop 1" : "+v"(kk), "+v"(nkka), "+v"(ne), "+v"(kp), "+v"(r));
          float sa0, sa1, sa2, sa3;
          DOT16(sa0, sa1, sa2, sa3, kk);
          UPD_A(ne, kp, vv);
          float sa = rowsum4((sa0 + sa1) + (sa2 + sa3));
          UPD_B(nkka, sa);
          float o0, o1, o2, o3;
          DOT16(o0, o1, o2, o3, r);
          op[u] = (o0 + o1) + (o2 + o3);
        }
        float a_ = op[0], c_ = op[2], b_ = op[1], d_ = op[3];
        asm volatile("s_nop 1\n\tv_permlane32_swap_b32 %0, %1" : "+v"(a_), "+v"(c_));
        asm volatile("s_nop 1\n\tv_permlane32_swap_b32 %0, %1" : "+v"(b_), "+v"(d_));
        float s02 = a_ + c_, s13 = b_ + d_;
        asm volatile("s_nop 1\n\tv_permlane16_swap_b32 %0, %1" : "+v"(s02), "+v"(s13));
        const float tot = s02 + s13;
        Oq[(ptrdiff_t)sgn * s * 1024] = f2b(tot);
      };
      bfr XA[4][6], XB[4][6];
#pragma unroll
      for (int u = 0; u < 4; u++) ld(u, XA[u]);
      for (int s0 = 0; s0 < 64; s0 += 8) {
#pragma unroll
        for (int u = 0; u < 4; u++) ld(s0 + 4 + u, XB[u]);
        group(XA, s0);
        if (s0 + 8 < 64) {
#pragma unroll
          for (int u = 0; u < 4; u++) ld(s0 + 8 + u, XA[u]);
        }
        group(XB, s0 + 4);
      }
    }
    __syncthreads();
  }
}

__device__ __forceinline__ void rwkv_scan_simple(const Pm& P, int unit) {
  const int tid = ftid();
  const int b = unit >> 5, h = (unit >> 1) & 15, dir = unit & 1;
  const bfr* R = WSP(bfr, OFF_R); const bfr* KP = WSP(bfr, OFF_KP); const bfr* V = WSP(bfr, OFF_V);
  const bfr* KKN = WSP(bfr, OFF_KKN); const bfr* AA = WSP(bfr, OFF_AA);
  const bfr* NE = dir ? WSP(bfr, OFF_NEB) : WSP(bfr, OFF_NEF);
  bfr* O = dir ? WSP(bfr, OFF_OB) : WSP(bfr, OFF_OF);
  const int v = tid >> 3, kq = tid & 7;
  float S[8];
#pragma unroll
  for (int j = 0; j < 8; j++) S[j] = 0.f;
  for (int p = 0; p < 4352; p++) {
    const size_t rw = (size_t)seq_row(p, b, dir) * 1024 + h * 64;
    const size_t ro = rw + kq * 8;
    u16x8 r8 = *(const u16x8*)(R + ro), kp8 = *(const u16x8*)(KP + ro), kk8 = *(const u16x8*)(KKN + ro);
    u16x8 aa8 = *(const u16x8*)(AA + ro), ne8 = *(const u16x8*)(NE + ro);
    const float vv = b2f(V[rw + v]);
    float sa = 0.f;
#pragma unroll
    for (int j = 0; j < 8; j++) sa += S[j] * b2f(kk8[j]);
    sa += __shfl_xor(sa, 1); sa += __shfl_xor(sa, 2); sa += __shfl_xor(sa, 4);
    float o = 0.f;
#pragma unroll
    for (int j = 0; j < 8; j++) {
      S[j] = S[j] + b2f(ne8[j]) * S[j] + sa * b2f(aa8[j]) + vv * b2f(kp8[j]);
      o += S[j] * b2f(r8[j]);
    }
    o += __shfl_xor(o, 1); o += __shfl_xor(o, 2); o += __shfl_xor(o, 4);
    if (kq == 0) O[rw + v] = f2b(o);
  }
}

constexpr int QS = 136;
constexpr int TS = 72;
__device__ __forceinline__ void gla_prep(const Pm& P, int l) {
  const bfr* PG = WSP(bfr, OFF_PGLA);
  unsigned short* CUM = WSP(unsigned short, OFF_CUM);
  const int nitems = 272 * 1024;
  for (int it = blockIdx.x * NTHR + ftid(); it < nitems; it += gridDim.x * NTHR) {
    const int c = it >> 10, col = it & 1023, dir = col >> 9, dd = col & 511;
    float a2c[16];
#pragma unroll
    for (int r = 0; r < 16; r++) a2c[r] = P.in[I_GA2][(((size_t)l * 2 + dir) * 16 + r) * 512 + dd];
    const float ab = P.in[I_GAB][((size_t)l * 2 + dir) * 512 + dd];
    float run = 0.f;
    for (int i = 0; i < 64; i++) {
      const int row = dir ? (64 * c + 63 - i) : (64 * c + i);
      const bfr* adp = PG + (size_t)row * NGLA + 3072 + dir * 16;
      u16x8 a0 = *(const u16x8*)adp, a1 = *(const u16x8*)(adp + 8);
      float x = ab;
#pragma unroll
      for (int r = 0; r < 8; r++) { x += b2f(a0[r]) * a2c[r]; x += b2f(a1[r]) * a2c[8 + r]; }
      const float lg = (fminf(x, 0.f) - __logf(1.0f + __expf(-fabsf(x)))) * (1.0f / 16.0f);
      run += lg;
      _Float16 hv = (_Float16)run;
      CUM[(size_t)row * 1024 + col] = __builtin_bit_cast(unsigned short, hv);
    }
  }
}
__device__ __forceinline__ float h2f(unsigned short u) { return (float)__builtin_bit_cast(_Float16, u); }

template <int NS>
__device__ __forceinline__ void chunk_scan(const Pm& P, int l, int unit, char* smem) {
  const int tid = ftid(), w = tid >> 6, lane = tid & 63, fr = lane & 15, fq = lane >> 4;
  const int b = unit >> 4, h = (unit >> 2) & 3, slice = unit & 3;
  constexpr int DK = 128 * NS;
  const bfr* Pb = (NS == 1) ? WSP(bfr, OFF_PGLA) : WSP(bfr, OFF_PRET);
  const unsigned short* CUM = WSP(unsigned short, OFF_CUM);
  constexpr int ldp = (NS == 1) ? NGLA : NRET;
  const int qoff = h * DK, koff = ((NS == 1) ? 512 : 1024) + h * DK;
  const int voff = ((NS == 1) ? 1024 : 2048) + h * 256 + slice * 64;
  bfr* O = (NS == 1) ? WSP(bfr, OFF_OGLA) : WSP(bfr, OFF_ORET);
  const int ocol = h * 256 + slice * 64;
  const float qscale = (NS == 1) ? 0.08838834764831845f : 1.0f;

  bfr* Qi = (bfr*)smem;
  bfr* Ki = (bfr*)(smem + 17408);
  bfr* KoT = (bfr*)(smem + 34816);
  bfr* VT = (bfr*)(smem + 53248);
  bfr* Pm_ = (bfr*)(smem + 62464);
  bfr* ST = (bfr*)(smem + 71680);
  float* lastv = (float*)(smem + 71680 + NS * 17408);

  const int d = tid & 127, tq = tid >> 7;
  const int t2 = tid >> 4, db = tid & 15;
  const int vc = tid & 63, tg = tid >> 6;
  const int mt = w >> 1, nb = (w & 1) * 2;

  for (int dir = 0; dir < 2; dir++) {
    const int sgn = dir ? -1 : 1;
    auto rbase_of = [&](int n) {
      if (n < 4) return dir ? (b * 256 + 255 - 64 * n) : (b * 256 + 64 * n);
      return dir ? (TC + b * 4096 + 4095 - 64 * (n - 4)) : (TC + b * 4096 + 64 * (n - 4));
    };
    f32x4 acc_st[NS][4];
#pragma unroll
    for (int s = 0; s < NS; s++)
#pragma unroll
      for (int v = 0; v < 4; v++) acc_st[s][v] = f32x4{0.f, 0.f, 0.f, 0.f};
    __syncthreads();
    for (int e = tid; e < NS * 64 * QS; e += NTHR) ST[e] = 0;
    float lgam = 0.f;
    if (NS == 2) lgam = -__expf(P.in[I_RDEC][((size_t)l * 2 + dir) * 4 + h]);
    const u16x8 z8 = {0, 0, 0, 0, 0, 0, 0, 0};
    u16x8 pq8[2], pk8[2], pc8[2];
    bfr pv[8], po_next[8], po_cur[8];
    unsigned short plast = 0;
    pq8[0] = pq8[1] = pk8[0] = pk8[1] = pc8[0] = pc8[1] = z8;
#pragma unroll
    for (int i = 0; i < 8; i++) { pv[i] = 0; po_next[i] = 0; po_cur[i] = 0; }
    auto issue = [&](int n, int s) {
      const int rb = rbase_of(n);
      if (s == 0) {
#pragma unroll
        for (int i = 0; i < 8; i++) pv[i] = Pb[(size_t)(rb + sgn * (8 * tg + i)) * ldp + voff + vc];
        if (NS == 1 && tid < 128) plast = CUM[(size_t)(rb + sgn * 63) * 1024 + dir * 512 + h * 128 + tid];
        if (dir) {
#pragma unroll
          for (int j = 0; j < 2; j++)
#pragma unroll
            for (int jj = 0; jj < 4; jj++)
              po_next[j * 4 + jj] = O[(size_t)(rb + sgn * (16 * mt + fq * 4 + jj)) * 1024 + ocol + 16 * (nb + j) + fr];
        }
      }
#pragma unroll
      for (int i = 0; i < 2; i++) {
        const int row = rb + sgn * (t2 + 32 * i);
        const size_t ro = (size_t)row * ldp;
        pq8[i] = *(const u16x8*)(Pb + ro + qoff + s * 128 + db * 8);
        pk8[i] = *(const u16x8*)(Pb + ro + koff + s * 128 + db * 8);
        if (NS == 1) pc8[i] = *(const u16x8*)(CUM + (size_t)row * 1024 + dir * 512 + h * 128 + db * 8);
      }
    };
    issue(0, 0);
    for (int n = 0; n < 68; n++) {
      const int rbase = rbase_of(n);
      __syncthreads();
      {
        u16x8 vv;
#pragma unroll
        for (int i = 0; i < 8; i++) vv[i] = pv[i];
        *(u16x8*)(VT + vc * TS + 8 * tg) = vv;
      }
#pragma unroll
      for (int i = 0; i < 8; i++) po_cur[i] = po_next[i];
      f32x4 acc_s[2], acc_o[2];
      acc_s[0] = acc_s[1] = acc_o[0] = acc_o[1] = f32x4{0.f, 0.f, 0.f, 0.f};
#pragma unroll
      for (int s = 0; s < NS; s++) {
        if (NS == 1) {
          if (tid < 128) lastv[tid] = h2f(plast);
        } else {
          if (tid < 128) lastv[s * 128 + tid] = 64.0f * lgam;
        }
#pragma unroll
        for (int i = 0; i < 2; i++) {
          const int t = t2 + 32 * i;
          u16x8 qo, ko;
          if (NS == 1) {
#pragma unroll
            for (int e = 0; e < 8; e++) {
              const float c = h2f(pc8[i][e]);
              qo[e] = f2b(b2f(pq8[i][e]) * qscale * __expf(c));
              ko[e] = f2b(b2f(pk8[i][e]) * __expf(-c));
            }
          } else {
            const float c = (float)(t + 1) * lgam;
            const float eq = __expf(c), ek = __expf(-c);
#pragma unroll
            for (int e = 0; e < 8; e++) {
              qo[e] = f2b(b2f(pq8[i][e]) * eq);
              ko[e] = f2b(b2f(pk8[i][e]) * ek);
            }
          }
          *(u16x8*)(Qi + t * QS + db * 8) = qo;
          *(u16x8*)(Ki + t * QS + db * 8) = ko;
        }
        if (s + 1 < NS) issue(n, s + 1);
        else if (n + 1 < 68) issue(n + 1, 0);
        __syncthreads();
        {
          u16x8 k0, k1;
#pragma unroll
          for (int i = 0; i < 8; i++) { k0[i] = Ki[(16 * tq + i) * QS + d]; k1[i] = Ki[(16 * tq + 8 + i) * QS + d]; }
          *(u16x8*)(KoT + d * TS + 16 * tq) = k0;
          *(u16x8*)(KoT + d * TS + 16 * tq + 8) = k1;
        }
#pragma unroll
        for (int kk = 0; kk < 4; kk++) {
          bf16x8 a = *(const bf16x8*)(Qi + (16 * mt + fr) * QS + kk * 32 + fq * 8);
#pragma unroll
          for (int j = 0; j < 2; j++) {
            const int nt = nb + j;
            if (nt <= mt) {
              bf16x8 bb = *(const bf16x8*)(Ki + (16 * nt + fr) * QS + kk * 32 + fq * 8);
              acc_s[j] = __builtin_amdgcn_mfma_f32_16x16x32_bf16(a, bb, acc_s[j], 0, 0, 0);
            }
            bf16x8 sb = *(const bf16x8*)(ST + s * 64 * QS + (16 * nt + fr) * QS + kk * 32 + fq * 8);
            acc_o[j] = __builtin_amdgcn_mfma_f32_16x16x32_bf16(a, sb, acc_o[j], 0, 0, 0);
          }
        }
        __syncthreads();
        {
#pragma unroll
          for (int kk = 0; kk < 2; kk++) {
            bf16x8 bb = *(const bf16x8*)(KoT + (16 * w + fr) * TS + kk * 32 + fq * 8);
#pragma unroll
            for (int vt = 0; vt < 4; vt++) {
              bf16x8 a = *(const bf16x8*)(VT + (16 * vt + fr) * TS + kk * 32 + fq * 8);
              acc_st[s][vt] = __builtin_amdgcn_mfma_f32_16x16x32_bf16(a, bb, acc_st[s][vt], 0, 0, 0);
            }
          }
          const float dec = __expf(lastv[s * 128 + 16 * w + fr]);
#pragma unroll
          for (int vt = 0; vt < 4; vt++) acc_st[s][vt] *= dec;
        }
        __syncthreads();
#pragma unroll
        for (int vt = 0; vt < 4; vt++)
#pragma unroll
          for (int j = 0; j < 4; j++) ST[s * 64 * QS + (16 * vt + fq * 4 + j) * QS + 16 * w + fr] = f2b(acc_st[s][vt][j]);
      }
#pragma unroll
      for (int j = 0; j < 2; j++) {
        const int nt = nb + j;
#pragma unroll
        for (int jj = 0; jj < 4; jj++) {
          const int t = 16 * mt + fq * 4 + jj, sc = 16 * nt + fr;
          float val = (sc <= t) ? acc_s[j][jj] : 0.f;
          Pm_[t * TS + sc] = f2b(val);
        }
      }
      __syncthreads();
#pragma unroll
      for (int kk = 0; kk < 2; kk++) {
        bf16x8 a = *(const bf16x8*)(Pm_ + (16 * mt + fr) * TS + kk * 32 + fq * 8);
#pragma unroll
        for (int j = 0; j < 2; j++) {
          bf16x8 bb = *(const bf16x8*)(VT + (16 * (nb + j) + fr) * TS + kk * 32 + fq * 8);
          acc_o[j] = __builtin_amdgcn_mfma_f32_16x16x32_bf16(a, bb, acc_o[j], 0, 0, 0);
        }
      }
#pragma unroll
      for (int j = 0; j < 2; j++)
#pragma unroll
        for (int jj = 0; jj < 4; jj++) {
          const int t = 16 * mt + fq * 4 + jj;
          bfr* addr = O + (size_t)(rbase + sgn * t) * 1024 + ocol + 16 * (nb + j) + fr;
          float val = acc_o[j][jj];
          if (dir) val += b2f(po_cur[j * 4 + jj]);
          *addr = f2b(val);
        }
    }
  }
}

__device__ __forceinline__ void finish(const Pm& P, int l, int row_begin = 0) {
  const int tid_ = ftid();
  const int lane = tid_ & 63, wid = tid_ >> 6;
  const int c0 = lane * 16;
  bfr* OF = WSP(bfr, OFF_OF); const bfr* OB = WSP(bfr, OFF_OB); const bfr* G = WSP(bfr, OFF_G);
  const bfr* R = WSP(bfr, OFF_R); const bfr* KP = WSP(bfr, OFF_KP); const bfr* V = WSP(bfr, OFF_V);
  bfr* OG = WSP(bfr, OFF_OGLA); bfr* OR_ = WSP(bfr, OFF_ORET);
  const bfr* PGL = WSP(bfr, OFF_PGLA); const bfr* PRT = WSP(bfr, OFF_PRET);
  const float* lng = P.in[I_LNG] + (size_t)l * 1024 + c0; const float* lnb = P.in[I_LNB] + (size_t)l * 1024 + c0;
  const float* rk = P.in[I_RK] + (size_t)l * 1024 + c0;
  const float* gng = P.in[I_GNG] + (size_t)l * 1024 + c0; const float* rng = P.in[I_RNG] + (size_t)l * 1024 + c0;
  for (int row = row_begin + blockIdx.x * 8 + wid; row < T; row += gridDim.x * 8) {
    const size_t ro = (size_t)row * 1024 + c0;
    {
      float o[16], rr[16], kk[16], vv[16], gg[16];
#pragma unroll
      for (int hh = 0; hh < 2; hh++) {
        u16x8 a = *(const u16x8*)(OF + ro + hh * 8), bq = *(const u16x8*)(OB + ro + hh * 8);
        u16x8 r8 = *(const u16x8*)(R + ro + hh * 8), k8 = *(const u16x8*)(KP + ro + hh * 8), v8 = *(const u16x8*)(V + ro + hh * 8);
        u16x8 g8 = *(const u16x8*)(G + ro + hh * 8);
#pragma unroll
        for (int e = 0; e < 8; e++) {
          o[hh * 8 + e] = b2f(a[e]) + b2f(bq[e]);
          rr[hh * 8 + e] = b2f(r8[e]); kk[hh * 8 + e] = b2f(k8[e]); vv[hh * 8 + e] = b2f(v8[e]); gg[hh * 8 + e] = b2f(g8[e]);
        }
      }
      float s1 = 0.f, sb = 0.f;
#pragma unroll
      for (int i = 0; i < 16; i++) { s1 += o[i]; sb += rr[i] * kk[i] * rk[i]; }
      s1 += __shfl_xor(s1, 1); s1 += __shfl_xor(s1, 2);
      sb += __shfl_xor(sb, 1); sb += __shfl_xor(sb, 2);
      const float mean = s1 * (1.0f / 64.0f);
      float s2 = 0.f;
#pragma unroll
      for (int i = 0; i < 16; i++) { o[i] -= mean; s2 += o[i] * o[i]; }
      s2 += __shfl_xor(s2, 1); s2 += __shfl_xor(s2, 2);
      const float rs = rsqrtf(s2 * (1.0f / 64.0f) + 64e-5f);
      u16x8 w0, w1;
#pragma unroll
      for (int i = 0; i < 16; i++) {
        float y = o[i] * rs * lng[i] + lnb[i];
        bfr ov = f2b((y + sb * vv[i]) * gg[i]);
        if (ZERO_BRANCH == 1) ov = 0;
        if (i < 8) w0[i] = ov; else w1[i - 8] = ov;
      }
      *(u16x8*)(OF + ro) = w0; *(u16x8*)(OF + ro + 8) = w1;
    }
#pragma unroll
    for (int mx = 0; mx < 2; mx++) {
      bfr* Ob = mx ? OR_ : OG;
      const bfr* gsrc = mx ? (PRT + (size_t)row * NRET + 3072 + c0) : (PGL + (size_t)row * NGLA + 2048 + c0);
      const float* ng = mx ? rng : gng;
      float o[16], gt[16];
#pragma unroll
      for (int hh = 0; hh < 2; hh++) {
        u16x8 a = *(const u16x8*)(Ob + ro + hh * 8), g8 = *(const u16x8*)(gsrc + hh * 8);
#pragma unroll
        for (int e = 0; e < 8; e++) { o[hh * 8 + e] = b2f(a[e]); gt[hh * 8 + e] = b2f(g8[e]); }
      }
      if (mx) {
        float s1 = 0.f;
#pragma unroll
        for (int i = 0; i < 16; i++) s1 += o[i];
        s1 += __shfl_xor(s1, 1); s1 += __shfl_xor(s1, 2); s1 += __shfl_xor(s1, 4); s1 += __shfl_xor(s1, 8);
        const float mean = s1 * (1.0f / 256.0f);
#pragma unroll
        for (int i = 0; i < 16; i++) o[i] -= mean;
      }
      float s2 = 0.f;
#pragma unroll
      for (int i = 0; i < 16; i++) s2 += o[i] * o[i];
      s2 += __shfl_xor(s2, 1); s2 += __shfl_xor(s2, 2); s2 += __shfl_xor(s2, 4); s2 += __shfl_xor(s2, 8);
      const float rs = rsqrtf(s2 * (1.0f / 256.0f) + 1e-5f);
      u16x8 w0, w1;
#pragma unroll
      for (int i = 0; i < 16; i++) {
        bfr ov = f2b(o[i] * rs * ng[i] * siluf_(gt[i]));
        if (ZERO_BRANCH == 2 + mx) ov = 0;
        if (i < 8) w0[i] = ov; else w1[i - 8] = ov;
      }
      *(u16x8*)(Ob + ro) = w0; *(u16x8*)(Ob + ro + 8) = w1;
    }
  }
}


constexpr int STAGE256 = 65536;
__device__ __forceinline__ void gemm256_stage(const bfr* __restrict__ A, int lda, const bfr* __restrict__ Bt, int ldb, int row0,
                                              int col0, int k0, char* st, int tid) {
#pragma unroll
  for (int s = 0; s < 2; s++) {
#pragma unroll
    for (int i = 0; i < 2; i++) {
      int c = tid + i * NTHR;
      int r = c >> 2, kc = (((c & 3) ^ ((0x1320 >> (r & 12)) & 3))) * 8;
      __builtin_amdgcn_global_load_lds((const unsigned*)(A + (size_t)(row0 + r) * lda + k0 + s * 32 + kc),
                                       (unsigned*)(st + s * 16384 + c * 16), 16, 0, 0);
      __builtin_amdgcn_global_load_lds((const unsigned*)(Bt + (size_t)(col0 + r) * ldb + k0 + s * 32 + kc),
                                       (unsigned*)(st + 32768 + s * 16384 + c * 16), 16, 0, 0);
    }
  }
}
__device__ __forceinline__ void gemm256_compute(const char* st, f32x4 (&acc)[8][4], int wr, int wc, int fr, int fq) {
  const int fqs = fq ^ ((0x1320 >> (fr & 12)) & 3);
#pragma unroll
  for (int s = 0; s < 2; s++) {
    bf16x8 b[4];
#pragma unroll
    for (int n = 0; n < 4; n++) b[n] = *(const bf16x8*)(st + 32768 + s * 16384 + ((wc * 64 + n * 16 + fr) * 32 + fqs * 8) * 2);
#pragma unroll
    for (int mh = 0; mh < 2; mh++) {
      bf16x8 a[4];
#pragma unroll
      for (int m = 0; m < 4; m++) a[m] = *(const bf16x8*)(st + s * 16384 + ((wr * 128 + mh * 64 + m * 16 + fr) * 32 + fqs * 8) * 2);
      __builtin_amdgcn_sched_barrier(0);
#pragma unroll
      for (int m = 0; m < 4; m++)
#pragma unroll
        for (int n = 0; n < 4; n++) acc[mh * 4 + m][n] = __builtin_amdgcn_mfma_f32_16x16x32_bf16(a[m], b[n], acc[mh * 4 + m][n], 0, 0, 0);
      __builtin_amdgcn_sched_barrier(0);
    }
  }
}
template <class Epi>
__device__ __forceinline__ void gemm_phase256(const bfr* A, int lda, const bfr* Bt, int ldb, int M, int N, int K, const Epi& epi,
                                              char* smem) {
  const int nM = M >> 8, nN = N >> 8, nk = K >> 6;
  const int tid = ftid(), wid = tid >> 6, lane = tid & 63;
  const int wr = wid >> 2, wc = wid & 3, fr = lane & 15, fq = lane >> 4;
  bool pre = false;
  for (int tile = blockIdx.x; tile < nM * nN; tile += gridDim.x) {
    int mt, nt;
    tile_map(tile, nM, nN, mt, nt);
    f32x4 acc[8][4];
#pragma unroll
    for (int m = 0; m < 8; m++)
#pragma unroll
      for (int n = 0; n < 4; n++) acc[m][n] = f32x4{0.f, 0.f, 0.f, 0.f};
    if (!pre) gemm256_stage(A, lda, Bt, ldb, mt * 256, nt * 256, 0, smem, tid);
#pragma unroll 1
    for (int kt = 0; kt < nk; kt++) {
      asm volatile("s_waitcnt vmcnt(0)" ::: "memory");
      __syncthreads();
      if (kt + 1 < nk) gemm256_stage(A, lda, Bt, ldb, mt * 256, nt * 256, (kt + 1) * 64, smem + ((kt + 1) & 1) * STAGE256, tid);
      gemm256_compute(smem + (kt & 1) * STAGE256, acc, wr, wc, fr, fq);
    }
    __syncthreads();
    pre = false;
    if (tile + (int)gridDim.x < nM * nN) {
      int mt2, nt2;
      tile_map(tile + (int)gridDim.x, nM, nN, mt2, nt2);
      gemm256_stage(A, lda, Bt, ldb, mt2 * 256, nt2 * 256, 0, smem, tid);
      pre = true;
    }
#pragma unroll
    for (int hh = 0; hh < 2; hh++) {
      f32x4 part[4][4];
#pragma unroll
      for (int m = 0; m < 4; m++)
#pragma unroll
        for (int n = 0; n < 4; n++) part[m][n] = acc[hh * 4 + m][n];
      epi(part, mt * 256 + wr * 128 + hh * 64, nt * 256 + wc * 64, fr, fq);
    }
  }
}

#define XB_TMO      128
#define XB_XCNT(j)  (256  + 64 * (j))
#define XB_XSUB(j)  (1280 + 64 * (j))
#define XB_XGEN(j)  (2304 + 64 * (j))
#define XB_TOP      3328
#define XB_TOPGEN   3392
#define XCD_BAR_WORDS 3456
#define XB_SPIN_CAP (1u << 18)
#define LAS __attribute__((address_space(3)))

__device__ __forceinline__ unsigned xb_ld(unsigned* p)              { return __hip_atomic_load(p, __ATOMIC_RELAXED, __HIP_MEMORY_SCOPE_AGENT); }
__device__ __forceinline__ unsigned xb_add(unsigned* p, unsigned v) { return __hip_atomic_fetch_add(p, v, __ATOMIC_RELAXED, __HIP_MEMORY_SCOPE_AGENT); }
__device__ __forceinline__ unsigned xb_xcc_id() { return (unsigned)__builtin_amdgcn_s_getreg((3 << 11) | 20) & 0xFu; }
#define XB_SPIN(cond, bar) do { unsigned _sp = 0; while (cond) { __builtin_amdgcn_s_sleep(1); \
    if ((++_sp & 255u) == 0u) { if (xb_ld(&(bar)[XB_TMO])) break; if (_sp > XB_SPIN_CAP) { atomicAdd(&(bar)[XB_TMO], 1u); break; } } } } while (0)

struct XcdBarrier {
    unsigned* bar; unsigned x;
    volatile LAS unsigned* st;
};

__device__ __forceinline__ XcdBarrier xcd_barrier_post(unsigned* bar, volatile LAS unsigned* st) {
    XcdBarrier b; b.bar = bar; b.x = xb_xcc_id(); b.st = st;
    if (threadIdx.x == 0) (void)xb_add(&bar[XB_XCNT(b.x)], 1u);
    return b;
}
__device__ __forceinline__ void xcd_barrier_complete(unsigned* bar, unsigned x, unsigned& nloc, unsigned& nx) {
    const unsigned G = gridDim.x * gridDim.y * gridDim.z;
    unsigned sum, cnt, mine, sp = 0u;
    for (;;) {
        sum = 0u; cnt = 0u; mine = 0u;
#pragma unroll
        for (unsigned j = 0; j < 16; ++j) { const unsigned c = xb_ld(&bar[XB_XCNT(j)]); sum += c; cnt += (c > 0u) ? 1u : 0u; mine = (j == x) ? c : mine; }
        if (sum == G) break;
        __builtin_amdgcn_s_sleep(1);
        if ((++sp & 255u) == 0u) { if (xb_ld(&bar[XB_TMO])) break; if (sp > XB_SPIN_CAP) { atomicAdd(&bar[XB_TMO], 1u); break; } }
    }
    nloc = mine > 0u ? mine : 1u; nx = cnt > 0u ? cnt : 1u;
}

__device__ __forceinline__ void xcd_barrier(const XcdBarrier& b) {
    asm volatile("s_waitcnt vmcnt(0)" ::: "memory");
    __syncthreads();
    if (threadIdx.x == 0) {
        unsigned* bar = b.bar;
        __builtin_amdgcn_s_waitcnt(0);
        unsigned nloc = b.st[0], nx = b.st[1];
        if (nloc == 0u) { xcd_barrier_complete(bar, b.x, nloc, nx); b.st[0] = nloc; b.st[1] = nx; }
        const unsigned old = xb_add(&bar[XB_XSUB(b.x)], 1u);
        const unsigned gen = old / nloc;
        if (old + 1u == (gen + 1u) * nloc) {
            __builtin_amdgcn_fence(__ATOMIC_RELEASE, "agent");
            asm volatile("s_waitcnt vmcnt(0)" ::: "memory");
            const unsigned og = xb_add(&bar[XB_TOP], 1u);
            const unsigned tg = og / nx;
            if (og + 1u == (tg + 1u) * nx) xb_add(&bar[XB_TOPGEN], 1u);
            else XB_SPIN(xb_ld(&bar[XB_TOPGEN]) == tg, bar);
            __builtin_amdgcn_fence(__ATOMIC_ACQUIRE, "agent");
            xb_add(&bar[XB_XGEN(b.x)], 1u);
            asm volatile("s_waitcnt vmcnt(0)" ::: "memory");
        } else {
            XB_SPIN(xb_ld(&bar[XB_XGEN(b.x)]) == gen, bar);
            __builtin_amdgcn_fence(__ATOMIC_ACQUIRE, "agent");
            asm volatile("s_waitcnt vmcnt(0)" ::: "memory");
        }
    }
    __syncthreads();
}


#define FRESH(Q) Pm Q = P0; asm volatile("" : "+s"(Q.ws))
__global__ void __launch_bounds__(NTHR) mega_kernel(Pm P0) {
  extern __shared__ __attribute__((aligned(16))) char smem[];
  cg::grid_group grid = cg::this_grid();
  unsigned* barw = (unsigned*)(P0.ws + OFF_BAR);
  if (blockIdx.x == 0) for (int i = threadIdx.x; i < XCD_BAR_WORDS; i += NTHR) barw[i] = 0u;
  if (threadIdx.x == 0) *(uint4*)(smem + 147456) = make_uint4(0u, 0u, 0u, 0u);
  grid.sync();
  XcdBarrier xb = xcd_barrier_post(barw, (volatile LAS unsigned*)(smem + 147456));

  for (int rep_ = 0; rep_ < ((REPEAT_MASK & 128) ? 2 : 1); rep_++) {
  { FRESH(P); phase_mod(P, smem); }
  { FRESH(P); convert_layer(P, 0, smem); }
  }
  xcd_barrier(xb);
  { FRESH(P); rowwise(P, 0, 0); }
  xcd_barrier(xb);

#pragma unroll 1
  for (int l = 0; l < DEPTH; l++) {
    for (int rep_ = 0; rep_ < ((REPEAT_MASK & 1) ? 2 : 1); rep_++) {
      { FRESH(P); gemm_phase256(WSP(bfr, OFF_A), 1024, WBF(W_RW), 1024, T, NRW + NGLA + NRET, 1024, EpiIn{P.ws, smem}, smem); }
    }
    xcd_barrier(xb);
    for (int rep_ = 0; rep_ < ((REPEAT_MASK & 64) ? 2 : 1); rep_++) { FRESH(P); rwkv_lerp(P, l); }
    { FRESH(P); ret_prep(P); }
    for (int rep_ = 0; rep_ < ((REPEAT_MASK & 64) ? 2 : 1); rep_++) { FRESH(P); gla_prep(P, l); }
    xcd_barrier(xb);
    {
      { FRESH(P); gemm_phase(WSP(bfr, OFF_SM) + 0, 320, WBF(W_L2F), 64, T, 1024, 64, EpiDecay{P.in[I_W0] + ((size_t)l * 2 + 0) * 1024, WSP(bfr, OFF_NEF), smem}, smem, 0, 0); }
      { FRESH(P); gemm_phase(WSP(bfr, OFF_SM) + 64, 320, WBF(W_L2B), 64, T, 1024, 64, EpiDecay{P.in[I_W0] + ((size_t)l * 2 + 1) * 1024, WSP(bfr, OFF_NEB), smem}, smem, 544, 0); }
      { FRESH(P); gemm_phase(WSP(bfr, OFF_SM) + 128, 320, WBF(W_LA2), 64, T, 1024, 64,
                 EpiA{P.in[I_A0] + (size_t)l * 1024, P.in[I_KK] + (size_t)l * 1024, P.in[I_KA] + (size_t)l * 1024, WSP(bfr, OFF_KP),
                      WSP(bfr, OFF_KKN), WSP(bfr, OFF_AA)}, smem, 1088, 0); }
      { FRESH(P); gemm_phase(WSP(bfr, OFF_SM) + 192, 320, WBF(W_LG2), 128, T, 1024, 128, EpiBf16{WSP(bfr, OFF_G), 1024, smem}, smem, 1632, 0); }
      if (l > 0) { FRESH(P); gemm_phase(WSP(bfr, OFF_V), 1024, WBF(W_LV1), 1024, T, 128, 1024, EpiBf16{WSP(bfr, OFF_U), 128, smem}, smem, 2176, 0); }
    }
    xcd_barrier(xb);
    if (l > 0) {
      { FRESH(P); gemm_phase(WSP(bfr, OFF_U), 128, WBF(W_LV2), 64, T, 1024, 64,
                 EpiVres{P.in[I_V0] + (size_t)(l - 1) * 1024, WSP(bfr, OFF_V), WSP(bfr, OFF_VF)}, smem, 0, 0); }
      xcd_barrier(xb);
    }
#pragma unroll 1
    for (int rep_ = 0; rep_ < ((REPEAT_MASK & 2) ? 2 : 1); rep_++)
#pragma unroll 1
    for (int u = blockIdx.x; u < 256; u += gridDim.x) {
      if (u < 128) { FRESH(P); if (SIMPLE_SCAN) rwkv_scan_simple(P, u); else rwkv_scan(P, u, smem); }
      else if (u < 192) { for (int r2_ = 0; r2_ < ((REPEAT_MASK & 16) ? 2 : 1); r2_++) { FRESH(P); chunk_scan<1>(P, l, u - 128, smem); } }
      else { for (int r2_ = 0; r2_ < ((REPEAT_MASK & 32) ? 2 : 1); r2_++) { FRESH(P); chunk_scan<2>(P, l, u - 192, smem); } }
    }
    xcd_barrier(xb);
    const int r0 = (l == DEPTH - 1) ? TC : 0;
    const int Mr = T - r0;
    { FRESH(P); finish(P, l, r0); }
    for (int rep_ = 0; rep_ < ((REPEAT_MASK & 4) ? 2 : 1); rep_++)
    { FRESH(P); gemm_phase256(WSP(bfr, OFF_A) + (size_t)r0 * 1024, 1024, WBF(W_GATE), 1024, Mr, NGATE, 1024, EpiSigmoid{WSP(bfr, OFF_PGATE) + (size_t)r0 * NGATE, NGATE, smem}, smem); }
    xcd_barrier(xb);
    for (int rep_ = 0; rep_ < ((REPEAT_MASK & 4) ? 2 : 1); rep_++) {
    { FRESH(P); gemm_phase(WSP(bfr, OFF_OF) + (size_t)r0 * 1024, 1024, WBF(W_BR), 1024, Mr, 1024, 1024, EpiBranch{WSP(bfr, OFF_PGATE) + (size_t)r0 * NGATE, WSP(bfr, OFF_MERGED) + (size_t)r0 * 1024, 0}, smem, 0, 0); }
    { FRESH(P); gemm_phase(WSP(bfr, OFF_OGLA) + (size_t)r0 * 1024, 1024, WBF(W_BR) + (size_t)1024 * 1024, 1024, Mr, 1024, 1024, EpiBranch{WSP(bfr, OFF_PGATE) + (size_t)r0 * NGATE, WSP(bfr, OFF_MERGED) + (size_t)r0 * 1024, 1}, smem, 0, 0); }
    { FRESH(P); gemm_phase(WSP(bfr, OFF_ORET) + (size_t)r0 * 1024, 1024, WBF(W_BR) + (size_t)2 * 1024 * 1024, 1024, Mr, 1024, 1024, EpiBranch{WSP(bfr, OFF_PGATE) + (size_t)r0 * NGATE, WSP(bfr, OFF_MERGED) + (size_t)r0 * 1024, 2}, smem, 0, 0); }
    }
    xcd_barrier(xb);
    for (int rep_ = 0; rep_ < ((REPEAT_MASK & 4) ? 2 : 1); rep_++)
    { FRESH(P); gemm_phase(WSP(bfr, OFF_MERGED) + (size_t)r0 * 1024, 1024, WBF(W_OUT), 1024, Mr, 1024, 1024, EpiF32{WSP(float, OFF_Y) + (size_t)r0 * 1024, 1024}, smem, 0, 0); }
    xcd_barrier(xb);
    { FRESH(P); rowwise(P, 1, l, r0); }
    xcd_barrier(xb);
    for (int rep_ = 0; rep_ < ((REPEAT_MASK & 8) ? 2 : 1); rep_++)
    { FRESH(P); gemm_phase256(WSP(bfr, OFF_A) + (size_t)r0 * 1024, 1024, WBF(W_1), 1024, Mr, 4096, 1024, EpiRelu2{WSP(bfr, OFF_H) + (size_t)r0 * 4096, 4096, smem}, smem); }
    xcd_barrier(xb);
    for (int rep_ = 0; rep_ < ((REPEAT_MASK & 8) ? 2 : 1); rep_++)
    { FRESH(P); gemm_phase(WSP(bfr, OFF_H) + (size_t)r0 * 4096, 4096, WBF(W_2), 4096, Mr, 1024, 4096, EpiF32{WSP(float, OFF_Y) + (size_t)r0 * 1024, 1024}, smem, 0, 0); }
    xcd_barrier(xb);
    { FRESH(P); rowwise(P, 2, l, r0); }
    for (int rep_ = 0; rep_ < ((REPEAT_MASK & 128) ? 2 : 1); rep_++) if (l + 1 < DEPTH) { FRESH(P); convert_layer(P, l + 1, smem); }
    xcd_barrier(xb);
  }
}

extern "C" void kernel_launch(void* const* d_in, const int* in_sizes, int n_in, void* d_out, int out_size, void* d_ws,
                              size_t ws_size, hipStream_t stream) {
  (void)in_sizes; (void)out_size;
  if (n_in < N_IN || ws_size < WS_NEED) {
    fprintf(stderr, "bad args: n_in %d ws %zu need %zu\n", n_in, ws_size, (size_t)WS_NEED);
    return;
  }
  static int grid_blocks = 0;
  if (!grid_blocks) {
    int dev = 0, cus = 0, per_cu = 0;
    hipGetDevice(&dev);
    hipDeviceGetAttribute(&cus, hipDeviceAttributeMultiprocessorCount, dev);
    hipFuncSetAttribute((const void*)mega_kernel, hipFuncAttributeMaxDynamicSharedMemorySize, SMEM_BYTES);
    hipOccupancyMaxActiveBlocksPerMultiprocessor(&per_cu, mega_kernel, NTHR, SMEM_BYTES);
    if (per_cu < 1) per_cu = 1;
    if (per_cu > 1) per_cu = 1;
    grid_blocks = cus * per_cu;
  }
  Pm p;
  memset(&p, 0, sizeof(p));
  for (int i = 0; i < N_IN; i++) p.in[i] = (const float*)d_in[i];
  p.out = (float*)d_out;
  p.ws = (char*)d_ws;
  void* args[] = {&p};
  hipError_t e = hipLaunchCooperativeKernel((void*)mega_kernel, dim3(grid_blocks), dim3(NTHR), args, SMEM_BYTES, stream);
  if (e != hipSuccess) fprintf(stderr, "cooperative launch failed: %s (grid %d)\n", hipGetErrorString(e), grid_blocks);
}
```

```cpp
#include <hip/hip_runtime.h>
#include <hip/hip_bf16.h>
#include <hip/hip_cooperative_groups.h>
#include <cstdio>
#include <cstdint>
#include <cstring>
namespace cg = cooperative_groups;

typedef unsigned short bfr;
using bf16x8 = __attribute__((ext_vector_type(8))) short;
using f32x4 = __attribute__((ext_vector_type(4))) float;
using u16x8 = __attribute__((ext_vector_type(8))) unsigned short;

constexpr int D = 1024, TC = 1024, TL = 16384, T = 17408, DEPTH = 4;
constexpr int NRW = 3584, NGLA = 3328, NRET = 4096, NGATE = 3072;
constexpr int D_IN = 13664;
constexpr int NTHR = 512;

enum { I_X = 0, I_C, I_CTX, I_CCTX, I_ADAW, I_ADAB, I_NPREMIX, I_NPOSTMIX, I_NPREMLP, I_NPOSTMLP, I_WIN, I_MU, I_W0,
       I_W2, I_A0, I_A2, I_G2, I_V0, I_V1, I_V2, I_KK, I_KA, I_RK, I_LNG, I_LNB, I_GA2, I_GAB, I_GNG, I_RDEC, I_RNG,
       I_WBR, I_WOUT, I_W1, I_W2M, N_IN };

constexpr size_t al256(size_t x) { return (x + 255) & ~size_t(255); }
constexpr size_t W_RW = 0;
constexpr size_t W_GLA = W_RW + (size_t)NRW * 1024;
constexpr size_t W_RET = W_GLA + (size_t)NGLA * 1024;
constexpr size_t W_GATE = W_RET + (size_t)NRET * 1024;
constexpr size_t W_BR = W_GATE + (size_t)NGATE * 1024;
constexpr size_t W_OUT = W_BR + (size_t)3 * 1024 * 1024;
constexpr size_t W_1 = W_OUT + (size_t)1024 * 1024;
constexpr size_t W_2 = W_1 + (size_t)4096 * 1024;
constexpr size_t W_L2F = W_2 + (size_t)4096 * 1024;
constexpr size_t W_L2B = W_L2F + 1024 * 64;
constexpr size_t W_LA2 = W_L2B + 1024 * 64;
constexpr size_t W_LG2 = W_LA2 + 1024 * 64;
constexpr size_t W_LV1 = W_LG2 + 1024 * 128;
constexpr size_t W_LV2 = W_LV1 + 128 * 1024;
constexpr size_t W_END = W_LV2 + 1024 * 64;

constexpr size_t SZ = (size_t)T * 1024 * 2;
constexpr size_t OFF_W = 0;
constexpr size_t OFF_XC = al256(W_END * 2);
constexpr size_t OFF_A = OFF_XC + (size_t)1024 * 1024 * 4;
constexpr size_t OFF_VF = OFF_A + SZ;
constexpr size_t OFF_MOD = OFF_VF + SZ;
constexpr size_t OFF_PRW = al256(OFF_MOD + (size_t)4 * 5 * 6144 * 4);
constexpr size_t OFF_PGLA = OFF_PRW + (size_t)T * NRW * 2;
constexpr size_t OFF_PRET = OFF_PGLA + (size_t)T * NGLA * 2;
constexpr size_t OFF_S7 = OFF_PRET + (size_t)T * NRET * 2;
constexpr size_t OFF_SM = OFF_S7 + 7 * SZ;
constexpr size_t OFF_U = OFF_SM + (size_t)T * 320 * 2;
constexpr size_t OFF_OGLA = OFF_U + (size_t)T * 128 * 2;
constexpr size_t OFF_ORET = OFF_OGLA + SZ;
constexpr size_t OFF_CUM = OFF_ORET + SZ;
constexpr size_t OFF_BAR = OFF_CUM + SZ;
constexpr size_t WS_NEED = OFF_BAR + 16384;
constexpr size_t OFF_OF = OFF_PRW, OFF_OB = OFF_PRW + SZ, OFF_G = OFF_PRW + 2 * SZ;
constexpr size_t OFF_MERGED = OFF_PGLA;
constexpr size_t OFF_Y = OFF_PRET;
constexpr size_t OFF_R = OFF_S7, OFF_KP = OFF_S7 + SZ, OFF_V = OFF_S7 + 2 * SZ, OFF_KKN = OFF_S7 + 3 * SZ,
                 OFF_AA = OFF_S7 + 4 * SZ, OFF_NEF = OFF_S7 + 5 * SZ, OFF_NEB = OFF_S7 + 6 * SZ;
constexpr size_t OFF_PGATE = OFF_S7 + 3 * SZ;
constexpr size_t OFF_H = OFF_S7;

constexpr int SMEM_BYTES = 147456 + 64;
#define SIMPLE_SCAN 0
#define REPEAT_MASK 0
#define ZERO_BRANCH 0


struct Pm {
  const float* in[N_IN];
  float* out;
  char* ws;
};

__device__ __forceinline__ bfr f2b(float f) {
  unsigned u = __float_as_uint(f);
  u += 0x7fffu + ((u >> 16) & 1u);
  return (bfr)(u >> 16);
}
__device__ __forceinline__ float b2f(bfr b) { return __uint_as_float(((unsigned)b) << 16); }
__device__ __forceinline__ float sigmoidf_(float x) { return 1.0f / (1.0f + __expf(-x)); }
__device__ __forceinline__ float siluf_(float x) { return x * sigmoidf_(x); }
__device__ __forceinline__ float wave_sum(float x) {
#pragma unroll
  for (int o = 32; o >= 1; o >>= 1) x += __shfl_xor(x, o);
  return x;
}
__device__ __forceinline__ int ftid() {
  int t = threadIdx.x;
  asm volatile("" : "+v"(t));
  return t;
}
#define WSP(T_, off) ((T_*)(P.ws + (off)))
#define WBF(off) ((bfr*)(P.ws + OFF_W) + (off))

__device__ __forceinline__ void conv_T(const float* __restrict__ src, int ld, int Ksrc, int Kdst, int nvalid, int npad, bfr* __restrict__ dst,
                       char* smem) {
  float* tile = (float*)smem;
  const int tid = ftid();
  const int nk = Kdst / 64, nn = npad / 64;
  for (int t = blockIdx.x; t < nk * nn; t += gridDim.x) {
    const int kt = t % nk, nt = t / nk;
    const int k0 = kt * 64, n0 = nt * 64;
#pragma unroll
    for (int i = 0; i < 2; i++) {
      const int e = tid + i * NTHR;
      const int kk = e >> 4, nq = (e & 15) * 4;
      float4 v = make_float4(0.f, 0.f, 0.f, 0.f);
      if (k0 + kk < Ksrc && n0 + nq < nvalid) v = *(const float4*)(src + (size_t)(k0 + kk) * ld + n0 + nq);
      float* tp = tile + kk * 65 + nq;
      tp[0] = v.x; tp[1] = v.y; tp[2] = v.z; tp[3] = v.w;
    }
    __syncthreads();
    {
      const int n = tid >> 3, kc = (tid & 7) * 8;
      u16x8 o;
#pragma unroll
      for (int i = 0; i < 8; i++) o[i] = f2b(tile[(kc + i) * 65 + n]);
      *(u16x8*)(dst + (size_t)(n0 + n) * Kdst + k0 + kc) = o;
    }
    __syncthreads();
  }
}

__device__ __forceinline__ void convert_layer(const Pm& P, int l, char* smem) {
  const float* win = P.in[I_WIN] + (size_t)l * 1024 * D_IN;
  conv_T(win + 0, D_IN, 1024, 1024, 3392, NRW, WBF(W_RW), smem);
  conv_T(win + 3392, D_IN, 1024, 1024, 3104, NGLA, WBF(W_GLA), smem);
  conv_T(win + 6496, D_IN, 1024, 1024, 4096, NRET, WBF(W_RET), smem);
  conv_T(win + 10592, D_IN, 1024, 1024, 3072, NGATE, WBF(W_GATE), smem);
  for (int i = 0; i < 3; i++)
    conv_T(P.in[I_WBR] + ((size_t)l * 3 + i) * 1024 * 1024, 1024, 1024, 1024, 1024, 1024, WBF(W_BR) + (size_t)i * 1024 * 1024,
           smem);
  conv_T(P.in[I_WOUT] + (size_t)l * 1024 * 1024, 1024, 1024, 1024, 1024, 1024, WBF(W_OUT), smem);
  conv_T(P.in[I_W1] + (size_t)l * 1024 * 4096, 4096, 1024, 1024, 4096, 4096, WBF(W_1), smem);
  conv_T(P.in[I_W2M] + (size_t)l * 4096 * 1024, 1024, 4096, 4096, 1024, 1024, WBF(W_2), smem);
  conv_T(P.in[I_W2] + ((size_t)l * 2 + 0) * 64 * 1024, 1024, 64, 64, 1024, 1024, WBF(W_L2F), smem);
  conv_T(P.in[I_W2] + ((size_t)l * 2 + 1) * 64 * 1024, 1024, 64, 64, 1024, 1024, WBF(W_L2B), smem);
  conv_T(P.in[I_A2] + (size_t)l * 64 * 1024, 1024, 64, 64, 1024, 1024, WBF(W_LA2), smem);
  conv_T(P.in[I_G2] + (size_t)l * 128 * 1024, 1024, 128, 128, 1024, 1024, WBF(W_LG2), smem);
  if (l > 0) {
    conv_T(P.in[I_V1] + (size_t)(l - 1) * 1024 * 32, 32, 1024, 1024, 32, 128, WBF(W_LV1), smem);
    conv_T(P.in[I_V2] + (size_t)(l - 1) * 32 * 1024, 1024, 32, 64, 1024, 1024, WBF(W_LV2), smem);
  }
}

__device__ __forceinline__ void phase_mod(const Pm& P, char* smem) {
  float* sc = (float*)smem;
  float* red = (float*)smem + 5 * 1024;
  const int tid = ftid();
  for (int e = tid; e < 5 * 1024; e += NTHR) {
    int r = e >> 10, k = e & 1023;
    float v = (r < 4) ? P.in[I_C][r * 1024 + k] : P.in[I_CCTX][k];
    sc[e] = siluf_(v);
  }
  __syncthreads();
  float* MODV = WSP(float, OFF_MOD);
  for (int item = blockIdx.x; item < 4 * 48; item += gridDim.x) {
    const int l = item / 48, cb = item % 48;
    const int col = cb * 128 + (tid & 127), kq = tid >> 7;
    const float* w = P.in[I_ADAW] + (size_t)l * 1024 * 6144 + col;
    float acc[5] = {0, 0, 0, 0, 0};
#pragma unroll 16
    for (int k = kq * 256; k < kq * 256 + 256; k++) {
      float wv = w[(size_t)k * 6144];
#pragma unroll
      for (int r = 0; r < 5; r++) acc[r] += sc[r * 1024 + k] * wv;
    }
#pragma unroll
    for (int r = 0; r < 5; r++) red[(kq * 5 + r) * 128 + (tid & 127)] = acc[r];
    __syncthreads();
    if (kq == 0) {
      float bias = P.in[I_ADAB][(size_t)l * 6144 + col];
#pragma unroll
      for (int r = 0; r < 5; r++) {
        float s = red[(0 * 5 + r) * 128 + tid] + red[(1 * 5 + r) * 128 + tid] + red[(2 * 5 + r) * 128 + tid] +
                  red[(3 * 5 + r) * 128 + tid];
        MODV[((size_t)l * 5 + r) * 6144 + col] = s + bias;
      }
    }
    __syncthreads();
  }
}

__device__ __forceinline__ void rowwise(const Pm& P, int mode, int l) {
  const int tid_ = ftid();
  const int lane = tid_ & 63, wid = tid_ >> 6;
  const float* MODV = WSP(float, OFF_MOD);
  const float* Y = WSP(float, OFF_Y);
  bfr* A = WSP(bfr, OFF_A);
  for (int row = blockIdx.x * 8 + wid; row < T; row += gridDim.x * 8) {
    float* xr = (row < TC) ? (WSP(float, OFF_XC) + (size_t)row * 1024) : (P.out + (size_t)(row - TC) * 1024);
    const int mrow = (row < TC) ? 4 : ((row - TC) >> 12);
    const float* md = MODV + ((size_t)l * 5 + mrow) * 6144;
    const int c0 = lane * 16;
    float x[16];
    const float* xsrc = xr;
    if (mode == 0) xsrc = (row < TC) ? (P.in[I_CTX] + (size_t)row * 1024) : (P.in[I_X] + (size_t)(row - TC) * 1024);
#pragma unroll
    for (int i = 0; i < 4; i++) {
      float4 v = *(const float4*)(xsrc + c0 + i * 4);
      x[i * 4 + 0] = v.x; x[i * 4 + 1] = v.y; x[i * 4 + 2] = v.z; x[i * 4 + 3] = v.w;
    }
    if (mode != 0) {
      float y[16];
      float ss = 0.f;
#pragma unroll
      for (int i = 0; i < 4; i++) {
        float4 v = *(const float4*)(Y + (size_t)row * 1024 + c0 + i * 4);
        y[i * 4 + 0] = v.x; y[i * 4 + 1] = v.y; y[i * 4 + 2] = v.z; y[i * 4 + 3] = v.w;
      }
#pragma unroll
      for (int i = 0; i < 16; i++) ss += y[i] * y[i];
      ss = wave_sum(ss);
      const float rs = rsqrtf(ss * (1.0f / 1024.0f) + 1e-6f);
      const float* gate = md + (mode == 1 ? 2 : 5) * 1024 + c0;
      const float* gp = P.in[mode == 1 ? I_NPOSTMIX : I_NPOSTMLP] + (size_t)l * 1024 + c0;
#pragma unroll
      for (int i = 0; i < 16; i++) x[i] += gate[i] * (y[i] * rs * gp[i]);
    }
    if (mode != 2 || true) {
#pragma unroll
      for (int i = 0; i < 4; i++) *(float4*)(xr + c0 + i * 4) = make_float4(x[i * 4], x[i * 4 + 1], x[i * 4 + 2], x[i * 4 + 3]);
    }
    if (mode == 2 && l + 1 >= DEPTH) continue;
    float ss2 = 0.f;
#pragma unroll
    for (int i = 0; i < 16; i++) ss2 += x[i] * x[i];
    ss2 = wave_sum(ss2);
    const float rs2 = rsqrtf(ss2 * (1.0f / 1024.0f) + 1e-6f);
    const float *gpre, *shift, *scale;
    if (mode == 0) {
      gpre = P.in[I_NPREMIX] + c0; shift = md + c0; scale = md + 1024 + c0;
    } else if (mode == 1) {
      gpre = P.in[I_NPREMLP] + (size_t)l * 1024 + c0; shift = md + 3 * 1024 + c0; scale = md + 4 * 1024 + c0;
    } else {
      const float* md2 = MODV + ((size_t)(l + 1) * 5 + mrow) * 6144;
      gpre = P.in[I_NPREMIX] + (size_t)(l + 1) * 1024 + c0; shift = md2 + c0; scale = md2 + 1024 + c0;
    }
    u16x8 o0, o1;
#pragma unroll
    for (int i = 0; i < 8; i++) {
      o0[i] = f2b((x[i] * rs2 * gpre[i]) * (1.0f + scale[i]) + shift[i]);
      o1[i] = f2b((x[i + 8] * rs2 * gpre[i + 8]) * (1.0f + scale[i + 8]) + shift[i + 8]);
    }
    *(u16x8*)(A + (size_t)row * 1024 + c0) = o0;
    *(u16x8*)(A + (size_t)row * 1024 + c0 + 8) = o1;
  }
}

constexpr int STAGE_BYTES = 49152;
__device__ __forceinline__ void gemm_stage(const bfr* __restrict__ A, int lda, const bfr* __restrict__ Bt, int ldb, int row0,
                                           int col0, int k0, char* st, int tid) {
#pragma unroll
  for (int s = 0; s < 2; s++) {
#pragma unroll
    for (int i = 0; i < 2; i++) {
      int c = tid + i * NTHR;
      int r = c >> 2, kc = (((c & 3) ^ ((0x1320 >> (r & 12)) & 3))) * 8;
      __builtin_amdgcn_global_load_lds((const unsigned*)(A + (size_t)(row0 + r) * lda + k0 + s * 32 + kc),
                                       (unsigned*)(st + s * 16384 + c * 16), 16, 0, 0);
    }
    {
      int c = tid;
      int r = c >> 2, kc = (((c & 3) ^ ((0x1320 >> (r & 12)) & 3))) * 8;
      __builtin_amdgcn_global_load_lds((const unsigned*)(Bt + (size_t)(col0 + r) * ldb + k0 + s * 32 + kc),
                                       (unsigned*)(st + 32768 + s * 8192 + c * 16), 16, 0, 0);
    }
  }
}
struct Frags { bf16x8 a[2][4], b[2][4]; };
__device__ __forceinline__ void gemm_load_frags(const char* st, Frags& f, int wr, int wc, int fr, int fq) {
  const int fqs = fq ^ ((0x1320 >> (fr & 12)) & 3);
#pragma unroll
  for (int s = 0; s < 2; s++) {
#pragma unroll
    for (int m = 0; m < 4; m++) f.a[s][m] = *(const bf16x8*)(st + s * 16384 + ((wr * 64 + m * 16 + fr) * 32 + fqs * 8) * 2);
#pragma unroll
    for (int n = 0; n < 4; n++) f.b[s][n] = *(const bf16x8*)(st + 32768 + s * 8192 + ((wc * 64 + n * 16 + fr) * 32 + fqs * 8) * 2);
  }
}
__device__ __forceinline__ void gemm_mfma(const Frags& f, f32x4 (&acc)[4][4]) {
#pragma unroll
  for (int s = 0; s < 2; s++) {
#pragma unroll
    for (int m = 0; m < 4; m++)
#pragma unroll
      for (int n = 0; n < 4; n++) acc[m][n] = __builtin_amdgcn_mfma_f32_16x16x32_bf16(f.a[s][m], f.b[s][n], acc[m][n], 0, 0, 0);
  }
}
__device__ __forceinline__ void gemm_kloop(const bfr* __restrict__ A, int lda, const bfr* __restrict__ Bt, int ldb, int row0,
                                           int col0, int K, char* smem, f32x4 (&acc)[4][4], int tid, bool pre) {
  const int wid = tid >> 6, lane = tid & 63;
  const int wr = wid >> 1, wc = wid & 1, fr = lane & 15, fq = lane >> 4;
  const int nk = K >> 6;
  const bool grpY = wid >= 4;
  if (!pre) {
    gemm_stage(A, lda, Bt, ldb, row0, col0, 0, smem, tid);
    if (nk > 1) gemm_stage(A, lda, Bt, ldb, row0, col0, 64, smem + STAGE_BYTES, tid);
  }
  Frags F;
#pragma unroll
  for (int s = 0; s < 2; s++)
#pragma unroll
    for (int m = 0; m < 4; m++) { F.a[s][m] = bf16x8{0, 0, 0, 0, 0, 0, 0, 0}; F.b[s][m] = bf16x8{0, 0, 0, 0, 0, 0, 0, 0}; }
  int cur = 0, nxt = 2;
  for (int kt = 0; kt < nk; kt++) {
    if (kt + 1 < nk) asm volatile("s_waitcnt vmcnt(6)" ::: "memory");
    else asm volatile("s_waitcnt vmcnt(0)" ::: "memory");
    __syncthreads();
    if (kt + 2 < nk) gemm_stage(A, lda, Bt, ldb, row0, col0, (kt + 2) * 64, smem + nxt * STAGE_BYTES, tid);
    if (grpY) gemm_mfma(F, acc);
    __builtin_amdgcn_sched_barrier(0);
    gemm_load_frags(smem + cur * STAGE_BYTES, F, wr, wc, fr, fq);
    __builtin_amdgcn_sched_barrier(0);
    if (!grpY) gemm_mfma(F, acc);
    cur = (cur == 2) ? 0 : cur + 1;
    nxt = (nxt == 2) ? 0 : nxt + 1;
  }
  if (grpY) gemm_mfma(F, acc);
  __syncthreads();
}
__device__ __forceinline__ void tile_map(int tile, int nM, int nN, int& mt, int& nt) {
  const int WGM = 16;
  int nig = WGM * nN, gid = tile / nig, fm = gid * WGM;
  int gs = min(nM - fm, WGM);
  mt = fm + (tile % nig) % gs;
  nt = (tile % nig) / gs;
}

template <class Epi>
__device__ __forceinline__ void gemm_phase(const bfr* A, int lda, const bfr* Bt, int ldb, int M, int N, int K, const Epi& epi, char* smem,
                           int tile_off, int tile_total) {
  const int nM = M >> 8, nN = N >> 7;
  const int tid = ftid(), wid = tid >> 6, lane = tid & 63;
  const int wr = wid >> 1, wc = wid & 1, fr = lane & 15, fq = lane >> 4;
  int first = blockIdx.x;
  int g0 = tile_off;
  int start = ((first - (g0 % (int)gridDim.x)) % (int)gridDim.x + (int)gridDim.x) % (int)gridDim.x;
  bool pre = false;
  for (int tile = start; tile < nM * nN; tile += gridDim.x) {
    int mt, nt;
    tile_map(tile, nM, nN, mt, nt);
    f32x4 acc[4][4];
#pragma unroll
    for (int m = 0; m < 4; m++)
#pragma unroll
      for (int n = 0; n < 4; n++) acc[m][n] = f32x4{0.f, 0.f, 0.f, 0.f};
    gemm_kloop(A, lda, Bt, ldb, mt * 256, nt * 128, K, smem, acc, tid, pre);
    pre = false;
    if (tile + (int)gridDim.x < nM * nN) {
      int mt2, nt2;
      tile_map(tile + (int)gridDim.x, nM, nN, mt2, nt2);
      gemm_stage(A, lda, Bt, ldb, mt2 * 256, nt2 * 128, 0, smem, tid);
      if (K > 64) gemm_stage(A, lda, Bt, ldb, mt2 * 256, nt2 * 128, 64, smem + STAGE_BYTES, tid);
      pre = true;
    }
    epi(acc, mt * 256 + wr * 64, nt * 128 + wc * 64, fr, fq);
  }
  (void)tile_total;
}

template <class F>
__device__ __forceinline__ void wave_store_bf16(f32x4 (&acc)[4][4], const F& f, bfr* C, int ldc, int rb, int cb, int fr, int fq,
                                                char* sm) {
  const int tid_ = threadIdx.x;
  const int lane = tid_ & 63;
  bfr* sc = (bfr*)(sm + 2 * STAGE_BYTES + (tid_ >> 6) * 6144);
#pragma unroll
  for (int half = 0; half < 2; half++) {
#pragma unroll
    for (int mm = 0; mm < 2; mm++)
#pragma unroll
      for (int n = 0; n < 4; n++)
#pragma unroll
        for (int j = 0; j < 4; j++)
          sc[(mm * 16 + fq * 4 + j) * 72 + n * 16 + fr] = f2b(f(acc[half * 2 + mm][n][j], cb + n * 16 + fr));
    __builtin_amdgcn_fence(__ATOMIC_RELEASE, "wavefront");
    __builtin_amdgcn_wave_barrier();
    __builtin_amdgcn_fence(__ATOMIC_ACQUIRE, "wavefront");
#pragma unroll
    for (int it = 0; it < 4; it++) {
      const int id = it * 64 + lane;
      const int rl = id >> 3, ch = id & 7;
      u16x8 v = *(const u16x8*)(sc + rl * 72 + ch * 8);
      *(u16x8*)(C + (size_t)(rb + half * 32 + rl) * ldc + cb + ch * 8) = v;
    }
    __builtin_amdgcn_fence(__ATOMIC_RELEASE, "wavefront");
    __builtin_amdgcn_wave_barrier();
    __builtin_amdgcn_fence(__ATOMIC_ACQUIRE, "wavefront");
  }
}
struct EpiBf16 {
  bfr* C; int ldc; char* sm;
  __device__ __forceinline__ void operator()(f32x4 (&acc)[4][4], int rb, int cb, int fr, int fq) const {
    wave_store_bf16(acc, [](float v, int) { return v; }, C, ldc, rb, cb, fr, fq, sm);
  }
};
struct EpiIn {
  char* ws; char* sm;
  __device__ __forceinline__ void operator()(f32x4 (&acc)[4][4], int rb, int cb, int fr, int fq) const {
    const int seg = (cb >= NRW) + (cb >= NRW + NGLA);
    const size_t off = (seg == 0) ? OFF_PRW : ((seg == 1) ? OFF_PGLA : OFF_PRET);
    const int ldc = (seg == 0) ? NRW : ((seg == 1) ? NGLA : NRET);
    const int c0 = cb - ((seg == 0) ? 0 : ((seg == 1) ? NRW : NRW + NGLA));
    wave_store_bf16(acc, [](float v, int) { return v; }, (bfr*)(ws + off), ldc, rb, c0, fr, fq, sm);
  }
};
struct EpiF32 {
  float* C; int ldc;
  __device__ __forceinline__ void operator()(f32x4 (&acc)[4][4], int rb, int cb, int fr, int fq) const {
#pragma unroll
    for (int m = 0; m < 4; m++)
#pragma unroll
      for (int n = 0; n < 4; n++)
#pragma unroll
        for (int j = 0; j < 4; j++) C[(size_t)(rb + m * 16 + fq * 4 + j) * ldc + cb + n * 16 + fr] = acc[m][n][j];
  }
};
struct EpiRelu2 {
  bfr* C; int ldc; char* sm;
  __device__ __forceinline__ void operator()(f32x4 (&acc)[4][4], int rb, int cb, int fr, int fq) const {
    wave_store_bf16(acc, [](float v, int) { float r = fmaxf(v, 0.f); return r * r; }, C, ldc, rb, cb, fr, fq, sm);
  }
};
struct EpiSigmoid {
  bfr* C; int ldc; char* sm;
  __device__ __forceinline__ void operator()(f32x4 (&acc)[4][4], int rb, int cb, int fr, int fq) const {
    wave_store_bf16(acc, [](float v, int) { return sigmoidf_(v); }, C, ldc, rb, cb, fr, fq, sm);
  }
};
struct EpiDecay {
  const float* w0; bfr* C; char* sm;
  __device__ __forceinline__ void operator()(f32x4 (&acc)[4][4], int rb, int cb, int fr, int fq) const {
    const float* w0_ = w0;
    wave_store_bf16(acc, [w0_](float v, int col) {
      float x = w0_[col] + v;
      float lw = -0.6065306597126334f * sigmoidf_(x);
      return __expf(lw) - 1.0f;
    }, C, 1024, rb, cb, fr, fq, sm);
  }
};
struct EpiA {
  const float *a0, *k_k, *k_a;
  bfr *KP, *KKN, *AA;
  __device__ __forceinline__ void operator()(f32x4 (&acc)[4][4], int rb, int cb, int fr, int fq) const {
    float a0c[4], kkc[4], kac[4];
#pragma unroll
    for (int n = 0; n < 4; n++) {
      int col = cb + n * 16 + fr;
      a0c[n] = a0[col]; kkc[n] = k_k[col]; kac[n] = k_a[col];
    }
#pragma unroll
    for (int m = 0; m < 4; m++)
#pragma unroll
      for (int j = 0; j < 4; j++) {
        const size_t rowoff = (size_t)(rb + m * 16 + fq * 4 + j) * 1024;
        float k0[4], kr[4], av[4];
        float ss = 0.f;
#pragma unroll
        for (int n = 0; n < 4; n++) {
          int col = cb + n * 16 + fr;
          k0[n] = b2f(KP[rowoff + col]);
          kr[n] = k0[n] * kkc[n];
          ss += kr[n] * kr[n];
          av[n] = sigmoidf_(a0c[n] + acc[m][n][j]);
        }
        ss += __shfl_xor(ss, 1); ss += __shfl_xor(ss, 2); ss += __shfl_xor(ss, 4); ss += __shfl_xor(ss, 8);
        const float rn = rsqrtf(fmaxf(ss, 1e-12f));
#pragma unroll
        for (int n = 0; n < 4; n++) {
          int col = cb + n * 16 + fr;
          KKN[rowoff + col] = f2b(kr[n] * rn);
          AA[rowoff + col] = f2b(-(kr[n] * rn) * av[n]);
          KP[rowoff + col] = f2b(k0[n] * (1.0f + (av[n] - 1.0f) * kac[n]));
        }
      }
  }
};
struct EpiVres {
  const float* v0b; bfr* V; const bfr* VF;
  __device__ __forceinline__ void operator()(f32x4 (&acc)[4][4], int rb, int cb, int fr, int fq) const {
#pragma unroll
    for (int n = 0; n < 4; n++) {
      const int col = cb + n * 16 + fr;
      const float bc = v0b[col];
#pragma unroll
      for (int m = 0; m < 4; m++)
#pragma unroll
        for (int j = 0; j < 4; j++) {
          size_t idx = (size_t)(rb + m * 16 + fq * 4 + j) * 1024 + col;
          float v0 = b2f(V[idx]), vf = b2f(VF[idx]);
          V[idx] = f2b(v0 + (vf - v0) * sigmoidf_(bc + acc[m][n][j]));
        }
    }
  }
};

struct EpiBranch {
  const bfr* PG; bfr* MG; int i;
  __device__ __forceinline__ void operator()(f32x4 (&acc)[4][4], int rb, int cb, int fr, int fq) const {
#pragma unroll
    for (int n = 0; n < 4; n++) {
      const int col = cb + n * 16 + fr;
#pragma unroll
      for (int m = 0; m < 4; m++)
#pragma unroll
        for (int j = 0; j < 4; j++) {
          const size_t r_ = (size_t)(rb + m * 16 + fq * 4 + j);
          float v = b2f(PG[r_ * NGATE + i * 1024 + col]) * acc[m][n][j];
          if (i > 0) v += b2f(MG[r_ * 1024 + col]);
          MG[r_ * 1024 + col] = f2b(v);
        }
    }
  }
};

__device__ __forceinline__ void rwkv_lerp(const Pm& P, int l) {
  const bfr* PR = WSP(bfr, OFF_PRW);
  const float* mu = P.in[I_MU] + (size_t)l * 3392;
  bfr* R = WSP(bfr, OFF_R); bfr* KP = WSP(bfr, OFF_KP); bfr* V = WSP(bfr, OFF_V); bfr* VF = WSP(bfr, OFF_VF);
  bfr* SM = WSP(bfr, OFF_SM);
  const long nitems = (long)T * 424;
  for (long it = (long)blockIdx.x * NTHR + ftid(); it < nitems; it += (long)gridDim.x * NTHR) {
    const int row = (int)(it / 424), j = (int)(it % 424);
    const int c0 = j * 8;
    const bfr* pr = PR + (size_t)row * NRW + c0;
    u16x8 p = *(const u16x8*)pr;
    u16x8 nb[4];
    const u16x8 zero = {0, 0, 0, 0, 0, 0, 0, 0};
    if (row < TC) {
      const int t = row & 255;
      nb[0] = (t > 0) ? *(const u16x8*)(pr - NRW) : zero;
      nb[1] = (t < 255) ? *(const u16x8*)(pr + NRW) : zero;
      nb[2] = nb[0]; nb[3] = nb[1];
    } else {
      const int t = (row - TC) & 4095;
      const int gx = t & 63, gy = t >> 6;
      nb[0] = (gx > 0) ? *(const u16x8*)(pr - NRW) : zero;
      nb[1] = (gx < 63) ? *(const u16x8*)(pr + NRW) : zero;
      nb[2] = (gy > 0) ? *(const u16x8*)(pr - (size_t)64 * NRW) : zero;
      nb[3] = (gy < 63) ? *(const u16x8*)(pr + (size_t)64 * NRW) : zero;
    }
    float o[8];
#pragma unroll
    for (int e = 0; e < 8; e++) {
      float pv = b2f(p[e]);
      float sv = b2f(nb[e & 3][e]);
      o[e] = pv + (sv - pv) * mu[c0 + e];
    }
    u16x8 ov;
    if (c0 < 3072) {
#pragma unroll
      for (int e = 0; e < 8; e++) ov[e] = f2b(o[e]);
      const int seg = c0 >> 10, cc = c0 & 1023;
      bfr* dst = (seg == 0) ? R : (seg == 1 ? KP : V);
      *(u16x8*)(dst + (size_t)row * 1024 + cc) = ov;
      if (seg == 2 && l == 0) *(u16x8*)(VF + (size_t)row * 1024 + cc) = ov;
    } else {
      const int cs = c0 - 3072;
#pragma unroll
      for (int e = 0; e < 8; e++) {
        float v = o[e];
        if (cs < 128) v = 1.0f - 2.0f / (1.0f + __expf(2.0f * v));
        else if (cs >= 192) v = sigmoidf_(v);
        ov[e] = f2b(v);
      }
      *(u16x8*)(SM + (size_t)row * 320 + cs) = ov;
    }
  }
}

__device__ __forceinline__ void ret_prep(const Pm& P) {
  bfr* PT = WSP(bfr, OFF_PRET);
  const long nitems = (long)T * 64;
  for (long it = (long)blockIdx.x * NTHR + ftid(); it < nitems; it += (long)gridDim.x * NTHR) {
    const int row = (int)(it >> 6), rem = (int)(it & 63);
    const int h = rem >> 4, i0 = (rem & 15) * 8;
    const float pos = (row < TC) ? (float)(row & 255) : (float)(256 + ((row - TC) & 4095));
    float cs[8], sn[8];
#pragma unroll
    for (int e = 0; e < 8; e++) {
      float invf = exp2f(-(float)(i0 + e) * (13.287712379549449f / 128.0f));
      float ang = pos * invf;
      sincosf(ang, &sn[e], &cs[e]);
    }
#pragma unroll
    for (int qk = 0; qk < 2; qk++) {
      bfr* base = PT + (size_t)row * NRET + qk * 1024 + h * 256 + i0;
      u16x8 t1 = *(u16x8*)base, t2 = *(u16x8*)(base + 128);
      const float scl = qk ? 0.0625f : 1.0f;
      u16x8 o1, o2;
#pragma unroll
      for (int e = 0; e < 8; e++) {
        float a = b2f(t1[e]), b = b2f(t2[e]);
        o1[e] = f2b((a * cs[e] - b * sn[e]) * scl);
        o2[e] = f2b((a * sn[e] + b * cs[e]) * scl);
      }
      *(u16x8*)base = o1;
      *(u16x8*)(base + 128) = o2;
    }
  }
}

#define FMAC_BC(acc, x, s, J) \
  asm("v_fmac_f32_dpp %0, %1, %2 row_newbcast:" #J " row_mask:0xf bank_mask:0xf" : "+v"(acc) : "v"(x), "v"(s))
#define DOT16(o0_, o1_, o2_, o3_, x_) asm("v_mul_f32_dpp %0, %4, %5 row_newbcast:0 row_mask:0xf bank_mask:0xf\n\t" \
  "v_mul_f32_dpp %1, %4, %6 row_newbcast:1 row_mask:0xf bank_mask:0xf\n\t" \
  "v_mul_f32_dpp %2, %4, %7 row_newbcast:2 row_mask:0xf bank_mask:0xf\n\t" \
  "v_mul_f32_dpp %3, %4, %8 row_newbcast:3 row_mask:0xf bank_mask:0xf\n\t" \
  "v_fmac_f32_dpp %0, %4, %9 row_newbcast:4 row_mask:0xf bank_mask:0xf\n\t" \
  "v_fmac_f32_dpp %1, %4, %10 row_newbcast:5 row_mask:0xf bank_mask:0xf\n\t" \
  "v_fmac_f32_dpp %2, %4, %11 row_newbcast:6 row_mask:0xf bank_mask:0xf\n\t" \
  "v_fmac_f32_dpp %3, %4, %12 row_newbcast:7 row_mask:0xf bank_mask:0xf\n\t" \
  "v_fmac_f32_dpp %0, %4, %13 row_newbcast:8 row_mask:0xf bank_mask:0xf\n\t" \
  "v_fmac_f32_dpp %1, %4, %14 row_newbcast:9 row_mask:0xf bank_mask:0xf\n\t" \
  "v_fmac_f32_dpp %2, %4, %15 row_newbcast:10 row_mask:0xf bank_mask:0xf\n\t" \
  "v_fmac_f32_dpp %3, %4, %16 row_newbcast:11 row_mask:0xf bank_mask:0xf\n\t" \
  "v_fmac_f32_dpp %0, %4, %17 row_newbcast:12 row_mask:0xf bank_mask:0xf\n\t" \
  "v_fmac_f32_dpp %1, %4, %18 row_newbcast:13 row_mask:0xf bank_mask:0xf\n\t" \
  "v_fmac_f32_dpp %2, %4, %19 row_newbcast:14 row_mask:0xf bank_mask:0xf\n\t" \
  "v_fmac_f32_dpp %3, %4, %20 row_newbcast:15 row_mask:0xf bank_mask:0xf\n\t" \
  : "=&v"(o0_), "=&v"(o1_), "=&v"(o2_), "=&v"(o3_) \
  : "v"(x_), "v"(S[0]), "v"(S[1]), "v"(S[2]), "v"(S[3]), "v"(S[4]), "v"(S[5]), "v"(S[6]), "v"(S[7]), "v"(S[8]), "v"(S[9]), "v"(S[10]), "v"(S[11]), "v"(S[12]), "v"(S[13]), "v"(S[14]), "v"(S[15]))
#define UPD_A(ne_, kp_, vv_) asm("v_fmac_f32_dpp %0, %16, %0 row_newbcast:0 row_mask:0xf bank_mask:0xf\n\t" \
  "v_fmac_f32_dpp %1, %16, %1 row_newbcast:1 row_mask:0xf bank_mask:0xf\n\t" \
  "v_fmac_f32_dpp %2, %16, %2 row_newbcast:2 row_mask:0xf bank_mask:0xf\n\t" \
  "v_fmac_f32_dpp %3, %16, %3 row_newbcast:3 row_mask:0xf bank_mask:0xf\n\t" \
  "v_fmac_f32_dpp %4, %16, %4 row_newbcast:4 row_mask:0xf bank_mask:0xf\n\t" \
  "v_fmac_f32_dpp %5, %16, %5 row_newbcast:5 row_mask:0xf bank_mask:0xf\n\t" \
  "v_fmac_f32_dpp %6, %16, %6 row_newbcast:6 row_mask:0xf bank_mask:0xf\n\t" \
  "v_fmac_f32_dpp %7, %16, %7 row_newbcast:7 row_mask:0xf bank_mask:0xf\n\t" \
  "v_fmac_f32_dpp %8, %16, %8 row_newbcast:8 row_mask:0xf bank_mask:0xf\n\t" \
  "v_fmac_f32_dpp %9, %16, %9 row_newbcast:9 row_mask:0xf bank_mask:0xf\n\t" \
  "v_fmac_f32_dpp %10, %16, %10 row_newbcast:10 row_mask:0xf bank_mask:0xf\n\t" \
  "v_fmac_f32_dpp %11, %16, %11 row_newbcast:11 row_mask:0xf bank_mask:0xf\n\t" \
  "v_fmac_f32_dpp %12, %16, %12 row_newbcast:12 row_mask:0xf bank_mask:0xf\n\t" \
  "v_fmac_f32_dpp %13, %16, %13 row_newbcast:13 row_mask:0xf bank_mask:0xf\n\t" \
  "v_fmac_f32_dpp %14, %16, %14 row_newbcast:14 row_mask:0xf bank_mask:0xf\n\t" \
  "v_fmac_f32_dpp %15, %16, %15 row_newbcast:15 row_mask:0xf bank_mask:0xf\n\t" \
  "v_fmac_f32_dpp %0, %17, %18 row_newbcast:0 row_mask:0xf bank_mask:0xf\n\t" \
  "v_fmac_f32_dpp %1, %17, %18 row_newbcast:1 row_mask:0xf bank_mask:0xf\n\t" \
  "v_fmac_f32_dpp %2, %17, %18 row_newbcast:2 row_mask:0xf bank_mask:0xf\n\t" \
  "v_fmac_f32_dpp %3, %17, %18 row_newbcast:3 row_mask:0xf bank_mask:0xf\n\t" \
  "v_fmac_f32_dpp %4, %17, %18 row_newbcast:4 row_mask:0xf bank_mask:0xf\n\t" \
  "v_fmac_f32_dpp %5, %17, %18 row_newbcast:5 row_mask:0xf bank_mask:0xf\n\t" \
  "v_fmac_f32_dpp %6, %17, %18 row_newbcast:6 row_mask:0xf bank_mask:0xf\n\t" \
  "v_fmac_f32_dpp %7, %17, %18 row_newbcast:7 row_mask:0xf bank_mask:0xf\n\t" \
  "v_fmac_f32_dpp %8, %17, %18 row_newbcast:8 row_mask:0xf bank_mask:0xf\n\t" \
  "v_fmac_f32_dpp %9, %17, %18 row_newbcast:9 row_mask:0xf bank_mask:0xf\n\t" \
  "v_fmac_f32_dpp %10, %17, %18 row_newbcast:10 row_mask:0xf bank_mask:0xf\n\t" \
  "v_fmac_f32_dpp %11, %17, %18 row_newbcast:11 row_mask:0xf bank_mask:0xf\n\t" \
  "v_fmac_f32_dpp %12, %17, %18 row_newbcast:12 row_mask:0xf bank_mask:0xf\n\t" \
  "v_fmac_f32_dpp %13, %17, %18 row_newbcast:13 row_mask:0xf bank_mask:0xf\n\t" \
  "v_fmac_f32_dpp %14, %17, %18 row_newbcast:14 row_mask:0xf bank_mask:0xf\n\t" \
  "v_fmac_f32_dpp %15, %17, %18 row_newbcast:15 row_mask:0xf bank_mask:0xf\n\t" \
  : "+v"(S[0]), "+v"(S[1]), "+v"(S[2]), "+v"(S[3]), "+v"(S[4]), "+v"(S[5]), "+v"(S[6]), "+v"(S[7]), "+v"(S[8]), "+v"(S[9]), "+v"(S[10]), "+v"(S[11]), "+v"(S[12]), "+v"(S[13]), "+v"(S[14]), "+v"(S[15]) \
  : "v"(ne_), "v"(kp_), "v"(vv_))
#define UPD_B(nkka_, sa_) asm("v_fmac_f32_dpp %0, %16, %17 row_newbcast:0 row_mask:0xf bank_mask:0xf\n\t" \
  "v_fmac_f32_dpp %1, %16, %17 row_newbcast:1 row_mask:0xf bank_mask:0xf\n\t" \
  "v_fmac_f32_dpp %2, %16, %17 row_newbcast:2 row_mask:0xf bank_mask:0xf\n\t" \
  "v_fmac_f32_dpp %3, %16, %17 row_newbcast:3 row_mask:0xf bank_mask:0xf\n\t" \
  "v_fmac_f32_dpp %4, %16, %17 row_newbcast:4 row_mask:0xf bank_mask:0xf\n\t" \
  "v_fmac_f32_dpp %5, %16, %17 row_newbcast:5 row_mask:0xf bank_mask:0xf\n\t" \
  "v_fmac_f32_dpp %6, %16, %17 row_newbcast:6 row_mask:0xf bank_mask:0xf\n\t" \
  "v_fmac_f32_dpp %7, %16, %17 row_newbcast:7 row_mask:0xf bank_mask:0xf\n\t" \
  "v_fmac_f32_dpp %8, %16, %17 row_newbcast:8 row_mask:0xf bank_mask:0xf\n\t" \
  "v_fmac_f32_dpp %9, %16, %17 row_newbcast:9 row_mask:0xf bank_mask:0xf\n\t" \
  "v_fmac_f32_dpp %10, %16, %17 row_newbcast:10 row_mask:0xf bank_mask:0xf\n\t" \
  "v_fmac_f32_dpp %11, %16, %17 row_newbcast:11 row_mask:0xf bank_mask:0xf\n\t" \
  "v_fmac_f32_dpp %12, %16, %17 row_newbcast:12 row_mask:0xf bank_mask:0xf\n\t" \
  "v_fmac_f32_dpp %13, %16, %17 row_newbcast:13 row_mask:0xf bank_mask:0xf\n\t" \
  "v_fmac_f32_dpp %14, %16, %17 row_newbcast:14 row_mask:0xf bank_mask:0xf\n\t" \
  "v_fmac_f32_dpp %15, %16, %17 row_newbcast:15 row_mask:0xf bank_mask:0xf\n\t" \
  : "+v"(S[0]), "+v"(S[1]), "+v"(S[2]), "+v"(S[3]), "+v"(S[4]), "+v"(S[5]), "+v"(S[6]), "+v"(S[7]), "+v"(S[8]), "+v"(S[9]), "+v"(S[10]), "+v"(S[11]), "+v"(S[12]), "+v"(S[13]), "+v"(S[14]), "+v"(S[15]) \
  : "v"(nkka_), "v"(sa_))
#define REP16(M) M(0) M(1) M(2) M(3) M(4) M(5) M(6) M(7) M(8) M(9) M(10) M(11) M(12) M(13) M(14) M(15)
__device__ __forceinline__ float rowsum4(float x) {
  float a = x, b = x;
  asm volatile("s_nop 1\n\tv_permlane32_swap_b32 %0, %1" : "+v"(a), "+v"(b));
  float s = a + b;
  float c = s, d = s;
  asm volatile("s_nop 1\n\tv_permlane16_swap_b32 %0, %1" : "+v"(c), "+v"(d));
  return c + d;
}
__device__ __forceinline__ int seq_row(int p, int b, int dir) {
  if (p < 256) return b * 256 + (dir ? 255 - p : p);
  int q = p - 256;
  return TC + b * 4096 + (dir ? 4095 - q : q);
}
__device__ __forceinline__ void rwkv_scan(const Pm& P, int unit, char* smem) {
  const int tid = ftid(), wid = tid >> 6, lane = tid & 63;
  const int b = unit >> 5, h = (unit >> 1) & 15, dir = unit & 1;
  const bfr* S7b = WSP(bfr, OFF_S7);
  bfr* O = dir ? WSP(bfr, OFF_OB) : WSP(bfr, OFF_OF);
  constexpr int CHB = 64 * 6 * 64 * 2;
  const int colv = h * 64 + (wid & 3) * 16 + (lane & 15);
  float S[16];
#pragma unroll
  for (int j = 0; j < 16; j++) S[j] = 0.f;
  const int lt = tid - 256;
  auto load_chunk = [&](int c, char* buf) {
#pragma unroll
    for (int i = 0; i < 12; i++) {
      const int idx = lt + 256 * i;
      const int step = idx / 48, rem = idx - step * 48;
      const int arr = rem >> 3, part = rem & 7;
      const int am = (arr == 0) ? 0 : (arr == 1) ? 1 : (arr == 2) ? 3 : (arr == 3) ? 4 : (arr == 4) ? (5 + dir) : 2;
      const bfr* src = S7b + (size_t)am * ((size_t)T * 1024) + (size_t)seq_row(c * 64 + step, b, dir) * 1024 + h * 64 + part * 8;
      __builtin_amdgcn_global_load_lds((const unsigned*)src, (unsigned*)(buf + idx * 16), 16, 0, 0);
    }
  };
  __syncthreads();
  if (wid >= 4) {
    load_chunk(0, smem);
    asm volatile("s_waitcnt vmcnt(0)" ::: "memory");
  }
  __syncthreads();
  for (int c = 0; c < 68; c++) {
    if (wid >= 4) {
      if (c + 1 < 68) load_chunk(c + 1, smem + ((c + 1) & 1) * CHB);
      asm volatile("s_waitcnt vmcnt(0)" ::: "memory");
    } else {
      const bfr* buf = (const bfr*)(smem + (c & 1) * CHB);
      const int q_ = lane >> 4;
      const int rbase_c = seq_row(c * 64, b, dir);
      const int sgn = dir ? -1 : 1;
      bfr* Oq = O + (size_t)(rbase_c + sgn * q_) * 1024 + colv;
      auto ld = [&](int s, bfr (&x)[6]) {
        const bfr* sp = buf + s * 384;
        x[0] = sp[lane]; x[1] = sp[64 + lane]; x[2] = sp[128 + lane]; x[3] = sp[192 + lane]; x[4] = sp[256 + lane];
        x[5] = sp[320 + wid * 16 + (lane & 15)];
      };
      auto group = [&](bfr (&X)[4][6], int s) {
        float op[4];
#pragma unroll
        for (int u = 0; u < 4; u++) {
          float r = b2f(X[u][0]), kp = b2f(X[u][1]), kk = b2f(X[u][2]), nkka = b2f(X[u][3]), ne = b2f(X[u][4]), vv = b2f(X[u][5]);
          asm volatile("s_nop 1" : "+v"(kk), "+v"(nkka), "+v"(ne), "+v"(kp), "+v"(r));
          float sa0, sa1, sa2, sa3;
          DOT16(sa0, sa1, sa2, sa3, kk);
          UPD_A(ne, kp, vv);
          float sa = rowsum4((sa0 + sa1) + (sa2 + sa3));
          UPD_B(nkka, sa);
          float o0, o1, o2, o3;
          DOT16(o0, o1, o2, o3, r);
          op[u] = (o0 + o1) + (o2 + o3);
        }
        float a_ = op[0], c_ = op[2], b_ = op[1], d_ = op[3];
        asm volatile("s_nop 1\n\tv_permlane32_swap_b32 %0, %1" : "+v"(a_), "+v"(c_));
        asm volatile("s_nop 1\n\tv_permlane32_swap_b32 %0, %1" : "+v"(b_), "+v"(d_));
        float s02 = a_ + c_, s13 = b_ + d_;
        asm volatile("s_nop 1\n\tv_permlane16_swap_b32 %0, %1" : "+v"(s02), "+v"(s13));
        const float tot = s02 + s13;
        Oq[(ptrdiff_t)sgn * s * 1024] = f2b(tot);
      };
      bfr XA[4][6], XB[4][6];
#pragma unroll
      for (int u = 0; u < 4; u++) ld(u, XA[u]);
      for (int s0 = 0; s0 < 64; s0 += 8) {
#pragma unroll
        for (int u = 0; u < 4; u++) ld(s0 + 4 + u, XB[u]);
        group(XA, s0);
        if (s0 + 8 < 64) {
#pragma unroll
          for (int u = 0; u < 4; u++) ld(s0 + 8 + u, XA[u]);
        }
        group(XB, s0 + 4);
      }
    }
    __syncthreads();
  }
}

__device__ __forceinline__ void rwkv_scan_simple(const Pm& P, int unit) {
  const int tid = ftid();
  const int b = unit >> 5, h = (unit >> 1) & 15, dir = unit & 1;
  const bfr* R = WSP(bfr, OFF_R); const bfr* KP = WSP(bfr, OFF_KP); const bfr* V = WSP(bfr, OFF_V);
  const bfr* KKN = WSP(bfr, OFF_KKN); const bfr* AA = WSP(bfr, OFF_AA);
  const bfr* NE = dir ? WSP(bfr, OFF_NEB) : WSP(bfr, OFF_NEF);
  bfr* O = dir ? WSP(bfr, OFF_OB) : WSP(bfr, OFF_OF);
  const int v = tid >> 3, kq = tid & 7;
  float S[8];
#pragma unroll
  for (int j = 0; j < 8; j++) S[j] = 0.f;
  for (int p = 0; p < 4352; p++) {
    const size_t rw = (size_t)seq_row(p, b, dir) * 1024 + h * 64;
    const size_t ro = rw + kq * 8;
    u16x8 r8 = *(const u16x8*)(R + ro), kp8 = *(const u16x8*)(KP + ro), kk8 = *(const u16x8*)(KKN + ro);
    u16x8 aa8 = *(const u16x8*)(AA + ro), ne8 = *(const u16x8*)(NE + ro);
    const float vv = b2f(V[rw + v]);
    float sa = 0.f;
#pragma unroll
    for (int j = 0; j < 8; j++) sa += S[j] * b2f(kk8[j]);
    sa += __shfl_xor(sa, 1); sa += __shfl_xor(sa, 2); sa += __shfl_xor(sa, 4);
    float o = 0.f;
#pragma unroll
    for (int j = 0; j < 8; j++) {
      S[j] = S[j] + b2f(ne8[j]) * S[j] + sa * b2f(aa8[j]) + vv * b2f(kp8[j]);
      o += S[j] * b2f(r8[j]);
    }
    o += __shfl_xor(o, 1); o += __shfl_xor(o, 2); o += __shfl_xor(o, 4);
    if (kq == 0) O[rw + v] = f2b(o);
  }
}

constexpr int QS = 136;
constexpr int TS = 72;
__device__ __forceinline__ void gla_prep(const Pm& P, int l) {
  const bfr* PG = WSP(bfr, OFF_PGLA);
  unsigned short* CUM = WSP(unsigned short, OFF_CUM);
  const int nitems = 272 * 1024;
  for (int it = blockIdx.x * NTHR + ftid(); it < nitems; it += gridDim.x * NTHR) {
    const int c = it >> 10, col = it & 1023, dir = col >> 9, dd = col & 511;
    float a2c[16];
#pragma unroll
    for (int r = 0; r < 16; r++) a2c[r] = P.in[I_GA2][(((size_t)l * 2 + dir) * 16 + r) * 512 + dd];
    const float ab = P.in[I_GAB][((size_t)l * 2 + dir) * 512 + dd];
    float run = 0.f;
    for (int i = 0; i < 64; i++) {
      const int row = dir ? (64 * c + 63 - i) : (64 * c + i);
      const bfr* adp = PG + (size_t)row * NGLA + 3072 + dir * 16;
      u16x8 a0 = *(const u16x8*)adp, a1 = *(const u16x8*)(adp + 8);
      float x = ab;
#pragma unroll
      for (int r = 0; r < 8; r++) { x += b2f(a0[r]) * a2c[r]; x += b2f(a1[r]) * a2c[8 + r]; }
      const float lg = (fminf(x, 0.f) - __logf(1.0f + __expf(-fabsf(x)))) * (1.0f / 16.0f);
      run += lg;
      _Float16 hv = (_Float16)run;
      CUM[(size_t)row * 1024 + col] = __builtin_bit_cast(unsigned short, hv);
    }
  }
}
__device__ __forceinline__ float h2f(unsigned short u) { return (float)__builtin_bit_cast(_Float16, u); }

template <int NS>
__device__ __forceinline__ void chunk_scan(const Pm& P, int l, int unit, char* smem) {
  const int tid = ftid(), w = tid >> 6, lane = tid & 63, fr = lane & 15, fq = lane >> 4;
  const int b = unit >> 4, h = (unit >> 2) & 3, slice = unit & 3;
  constexpr int DK = 128 * NS;
  const bfr* Pb = (NS == 1) ? WSP(bfr, OFF_PGLA) : WSP(bfr, OFF_PRET);
  const unsigned short* CUM = WSP(unsigned short, OFF_CUM);
  constexpr int ldp = (NS == 1) ? NGLA : NRET;
  const int qoff = h * DK, koff = ((NS == 1) ? 512 : 1024) + h * DK;
  const int voff = ((NS == 1) ? 1024 : 2048) + h * 256 + slice * 64;
  bfr* O = (NS == 1) ? WSP(bfr, OFF_OGLA) : WSP(bfr, OFF_ORET);
  const int ocol = h * 256 + slice * 64;
  const float qscale = (NS == 1) ? 0.08838834764831845f : 1.0f;

  bfr* Qi = (bfr*)smem;
  bfr* Ki = (bfr*)(smem + 17408);
  bfr* KoT = (bfr*)(smem + 34816);
  bfr* VT = (bfr*)(smem + 53248);
  bfr* Pm_ = (bfr*)(smem + 62464);
  bfr* ST = (bfr*)(smem + 71680);
  float* lastv = (float*)(smem + 71680 + NS * 17408);

  const int d = tid & 127, tq = tid >> 7;
  const int t2 = tid >> 4, db = tid & 15;
  const int vc = tid & 63, tg = tid >> 6;
  const int mt = w >> 1, nb = (w & 1) * 2;

  for (int dir = 0; dir < 2; dir++) {
    const int sgn = dir ? -1 : 1;
    auto rbase_of = [&](int n) {
      if (n < 4) return dir ? (b * 256 + 255 - 64 * n) : (b * 256 + 64 * n);
      return dir ? (TC + b * 4096 + 4095 - 64 * (n - 4)) : (TC + b * 4096 + 64 * (n - 4));
    };
    f32x4 acc_st[NS][4];
#pragma unroll
    for (int s = 0; s < NS; s++)
#pragma unroll
      for (int v = 0; v < 4; v++) acc_st[s][v] = f32x4{0.f, 0.f, 0.f, 0.f};
    __syncthreads();
    for (int e = tid; e < NS * 64 * QS; e += NTHR) ST[e] = 0;
    float lgam = 0.f;
    if (NS == 2) lgam = -__expf(P.in[I_RDEC][((size_t)l * 2 + dir) * 4 + h]);
    const u16x8 z8 = {0, 0, 0, 0, 0, 0, 0, 0};
    u16x8 pq8[2], pk8[2], pc8[2];
    bfr pv[8], po_next[8], po_cur[8];
    unsigned short plast = 0;
    pq8[0] = pq8[1] = pk8[0] = pk8[1] = pc8[0] = pc8[1] = z8;
#pragma unroll
    for (int i = 0; i < 8; i++) { pv[i] = 0; po_next[i] = 0; po_cur[i] = 0; }
    auto issue = [&](int n, int s) {
      const int rb = rbase_of(n);
      if (s == 0) {
#pragma unroll
        for (int i = 0; i < 8; i++) pv[i] = Pb[(size_t)(rb + sgn * (8 * tg + i)) * ldp + voff + vc];
        if (NS == 1 && tid < 128) plast = CUM[(size_t)(rb + sgn * 63) * 1024 + dir * 512 + h * 128 + tid];
        if (dir) {
#pragma unroll
          for (int j = 0; j < 2; j++)
#pragma unroll
            for (int jj = 0; jj < 4; jj++)
              po_next[j * 4 + jj] = O[(size_t)(rb + sgn * (16 * mt + fq * 4 + jj)) * 1024 + ocol + 16 * (nb + j) + fr];
        }
      }
#pragma unroll
      for (int i = 0; i < 2; i++) {
        const int row = rb + sgn * (t2 + 32 * i);
        const size_t ro = (size_t)row * ldp;
        pq8[i] = *(const u16x8*)(Pb + ro + qoff + s * 128 + db * 8);
        pk8[i] = *(const u16x8*)(Pb + ro + koff + s * 128 + db * 8);
        if (NS == 1) pc8[i] = *(const u16x8*)(CUM + (size_t)row * 1024 + dir * 512 + h * 128 + db * 8);
      }
    };
    issue(0, 0);
    for (int n = 0; n < 68; n++) {
      const int rbase = rbase_of(n);
      __syncthreads();
      {
        u16x8 vv;
#pragma unroll
        for (int i = 0; i < 8; i++) vv[i] = pv[i];
        *(u16x8*)(VT + vc * TS + 8 * tg) = vv;
      }
#pragma unroll
      for (int i = 0; i < 8; i++) po_cur[i] = po_next[i];
      f32x4 acc_s[2], acc_o[2];
      acc_s[0] = acc_s[1] = acc_o[0] = acc_o[1] = f32x4{0.f, 0.f, 0.f, 0.f};
#pragma unroll
      for (int s = 0; s < NS; s++) {
        if (NS == 1) {
          if (tid < 128) lastv[tid] = h2f(plast);
        } else {
          if (tid < 128) lastv[s * 128 + tid] = 64.0f * lgam;
        }
#pragma unroll
        for (int i = 0; i < 2; i++) {
          const int t = t2 + 32 * i;
          u16x8 qo, ko;
          if (NS == 1) {
#pragma unroll
            for (int e = 0; e < 8; e++) {
              const float c = h2f(pc8[i][e]);
              qo[e] = f2b(b2f(pq8[i][e]) * qscale * __expf(c));
              ko[e] = f2b(b2f(pk8[i][e]) * __expf(-c));
            }
          } else {
            const float c = (float)(t + 1) * lgam;
            const float eq = __expf(c), ek = __expf(-c);
#pragma unroll
            for (int e = 0; e < 8; e++) {
              qo[e] = f2b(b2f(pq8[i][e]) * eq);
              ko[e] = f2b(b2f(pk8[i][e]) * ek);
            }
          }
          *(u16x8*)(Qi + t * QS + db * 8) = qo;
          *(u16x8*)(Ki + t * QS + db * 8) = ko;
        }
        if (s + 1 < NS) issue(n, s + 1);
        else if (n + 1 < 68) issue(n + 1, 0);
        __syncthreads();
        {
          u16x8 k0, k1;
#pragma unroll
          for (int i = 0; i < 8; i++) { k0[i] = Ki[(16 * tq + i) * QS + d]; k1[i] = Ki[(16 * tq + 8 + i) * QS + d]; }
          *(u16x8*)(KoT + d * TS + 16 * tq) = k0;
          *(u16x8*)(KoT + d * TS + 16 * tq + 8) = k1;
        }
#pragma unroll
        for (int kk = 0; kk < 4; kk++) {
          bf16x8 a = *(const bf16x8*)(Qi + (16 * mt + fr) * QS + kk * 32 + fq * 8);
#pragma unroll
          for (int j = 0; j < 2; j++) {
            const int nt = nb + j;
            if (nt <= mt) {
              bf16x8 bb = *(const bf16x8*)(Ki + (16 * nt + fr) * QS + kk * 32 + fq * 8);
              acc_s[j] = __builtin_amdgcn_mfma_f32_16x16x32_bf16(a, bb, acc_s[j], 0, 0, 0);
            }
            bf16x8 sb = *(const bf16x8*)(ST + s * 64 * QS + (16 * nt + fr) * QS + kk * 32 + fq * 8);
            acc_o[j] = __builtin_amdgcn_mfma_f32_16x16x32_bf16(a, sb, acc_o[j], 0, 0, 0);
          }
        }
        __syncthreads();
        {
#pragma unroll
          for (int kk = 0; kk < 2; kk++) {
            bf16x8 bb = *(const bf16x8*)(KoT + (16 * w + fr) * TS + kk * 32 + fq * 8);
#pragma unroll
            for (int vt = 0; vt < 4; vt++) {
              bf16x8 a = *(const bf16x8*)(VT + (16 * vt + fr) * TS + kk * 32 + fq * 8);
              acc_st[s][vt] = __builtin_amdgcn_mfma_f32_16x16x32_bf16(a, bb, acc_st[s][vt], 0, 0, 0);
            }
          }
          const float dec = __expf(lastv[s * 128 + 16 * w + fr]);
#pragma unroll
          for (int vt = 0; vt < 4; vt++) acc_st[s][vt] *= dec;
        }
        __syncthreads();
#pragma unroll
        for (int vt = 0; vt < 4; vt++)
#pragma unroll
          for (int j = 0; j < 4; j++) ST[s * 64 * QS + (16 * vt + fq * 4 + j) * QS + 16 * w + fr] = f2b(acc_st[s][vt][j]);
      }
#pragma unroll
      for (int j = 0; j < 2; j++) {
        const int nt = nb + j;
#pragma unroll
        for (int jj = 0; jj < 4; jj++) {
          const int t = 16 * mt + fq * 4 + jj, sc = 16 * nt + fr;
          float val = (sc <= t) ? acc_s[j][jj] : 0.f;
          Pm_[t * TS + sc] = f2b(val);
        }
      }
      __syncthreads();
#pragma unroll
      for (int kk = 0; kk < 2; kk++) {
        bf16x8 a = *(const bf16x8*)(Pm_ + (16 * mt + fr) * TS + kk * 32 + fq * 8);
#pragma unroll
        for (int j = 0; j < 2; j++) {
          bf16x8 bb = *(const bf16x8*)(VT + (16 * (nb + j) + fr) * TS + kk * 32 + fq * 8);
          acc_o[j] = __builtin_amdgcn_mfma_f32_16x16x32_bf16(a, bb, acc_o[j], 0, 0, 0);
        }
      }
#pragma unroll
      for (int j = 0; j < 2; j++)
#pragma unroll
        for (int jj = 0; jj < 4; jj++) {
          const int t = 16 * mt + fq * 4 + jj;
          bfr* addr = O + (size_t)(rbase + sgn * t) * 1024 + ocol + 16 * (nb + j) + fr;
          float val = acc_o[j][jj];
          if (dir) val += b2f(po_cur[j * 4 + jj]);
          *addr = f2b(val);
        }
    }
  }
}

__device__ __forceinline__ void finish(const Pm& P, int l) {
  const int tid_ = ftid();
  const int lane = tid_ & 63, wid = tid_ >> 6;
  const int c0 = lane * 16;
  bfr* OF = WSP(bfr, OFF_OF); const bfr* OB = WSP(bfr, OFF_OB); const bfr* G = WSP(bfr, OFF_G);
  const bfr* R = WSP(bfr, OFF_R); const bfr* KP = WSP(bfr, OFF_KP); const bfr* V = WSP(bfr, OFF_V);
  bfr* OG = WSP(bfr, OFF_OGLA); bfr* OR_ = WSP(bfr, OFF_ORET);
  const bfr* PGL = WSP(bfr, OFF_PGLA); const bfr* PRT = WSP(bfr, OFF_PRET);
  const float* lng = P.in[I_LNG] + (size_t)l * 1024 + c0; const float* lnb = P.in[I_LNB] + (size_t)l * 1024 + c0;
  const float* rk = P.in[I_RK] + (size_t)l * 1024 + c0;
  const float* gng = P.in[I_GNG] + (size_t)l * 1024 + c0; const float* rng = P.in[I_RNG] + (size_t)l * 1024 + c0;
  for (int row = blockIdx.x * 8 + wid; row < T; row += gridDim.x * 8) {
    const size_t ro = (size_t)row * 1024 + c0;
    {
      float o[16], rr[16], kk[16], vv[16], gg[16];
#pragma unroll
      for (int hh = 0; hh < 2; hh++) {
        u16x8 a = *(const u16x8*)(OF + ro + hh * 8), bq = *(const u16x8*)(OB + ro + hh * 8);
        u16x8 r8 = *(const u16x8*)(R + ro + hh * 8), k8 = *(const u16x8*)(KP + ro + hh * 8), v8 = *(const u16x8*)(V + ro + hh * 8);
        u16x8 g8 = *(const u16x8*)(G + ro + hh * 8);
#pragma unroll
        for (int e = 0; e < 8; e++) {
          o[hh * 8 + e] = b2f(a[e]) + b2f(bq[e]);
          rr[hh * 8 + e] = b2f(r8[e]); kk[hh * 8 + e] = b2f(k8[e]); vv[hh * 8 + e] = b2f(v8[e]); gg[hh * 8 + e] = b2f(g8[e]);
        }
      }
      float s1 = 0.f, sb = 0.f;
#pragma unroll
      for (int i = 0; i < 16; i++) { s1 += o[i]; sb += rr[i] * kk[i] * rk[i]; }
      s1 += __shfl_xor(s1, 1); s1 += __shfl_xor(s1, 2);
      sb += __shfl_xor(sb, 1); sb += __shfl_xor(sb, 2);
      const float mean = s1 * (1.0f / 64.0f);
      float s2 = 0.f;
#pragma unroll
      for (int i = 0; i < 16; i++) { o[i] -= mean; s2 += o[i] * o[i]; }
      s2 += __shfl_xor(s2, 1); s2 += __shfl_xor(s2, 2);
      const float rs = rsqrtf(s2 * (1.0f / 64.0f) + 64e-5f);
      u16x8 w0, w1;
#pragma unroll
      for (int i = 0; i < 16; i++) {
        float y = o[i] * rs * lng[i] + lnb[i];
        bfr ov = f2b((y + sb * vv[i]) * gg[i]);
        if (ZERO_BRANCH == 1) ov = 0;
        if (i < 8) w0[i] = ov; else w1[i - 8] = ov;
      }
      *(u16x8*)(OF + ro) = w0; *(u16x8*)(OF + ro + 8) = w1;
    }
#pragma unroll
    for (int mx = 0; mx < 2; mx++) {
      bfr* Ob = mx ? OR_ : OG;
      const bfr* gsrc = mx ? (PRT + (size_t)row * NRET + 3072 + c0) : (PGL + (size_t)row * NGLA + 2048 + c0);
      const float* ng = mx ? rng : gng;
      float o[16], gt[16];
#pragma unroll
      for (int hh = 0; hh < 2; hh++) {
        u16x8 a = *(const u16x8*)(Ob + ro + hh * 8), g8 = *(const u16x8*)(gsrc + hh * 8);
#pragma unroll
        for (int e = 0; e < 8; e++) { o[hh * 8 + e] = b2f(a[e]); gt[hh * 8 + e] = b2f(g8[e]); }
      }
      if (mx) {
        float s1 = 0.f;
#pragma unroll
        for (int i = 0; i < 16; i++) s1 += o[i];
        s1 += __shfl_xor(s1, 1); s1 += __shfl_xor(s1, 2); s1 += __shfl_xor(s1, 4); s1 += __shfl_xor(s1, 8);
        const float mean = s1 * (1.0f / 256.0f);
#pragma unroll
        for (int i = 0; i < 16; i++) o[i] -= mean;
      }
      float s2 = 0.f;
#pragma unroll
      for (int i = 0; i < 16; i++) s2 += o[i] * o[i];
      s2 += __shfl_xor(s2, 1); s2 += __shfl_xor(s2, 2); s2 += __shfl_xor(s2, 4); s2 += __shfl_xor(s2, 8);
      const float rs = rsqrtf(s2 * (1.0f / 256.0f) + 1e-5f);
      u16x8 w0, w1;
#pragma unroll
      for (int i = 0; i < 16; i++) {
        bfr ov = f2b(o[i] * rs * ng[i] * siluf_(gt[i]));
        if (ZERO_BRANCH == 2 + mx) ov = 0;
        if (i < 8) w0[i] = ov; else w1[i - 8] = ov;
      }
      *(u16x8*)(Ob + ro) = w0; *(u16x8*)(Ob + ro + 8) = w1;
    }
  }
}


constexpr int STAGE256 = 65536;
__device__ __forceinline__ void gemm256_stage(const bfr* __restrict__ A, int lda, const bfr* __restrict__ Bt, int ldb, int row0,
                                              int col0, int k0, char* st, int tid) {
#pragma unroll
  for (int s = 0; s < 2; s++) {
#pragma unroll
    for (int i = 0; i < 2; i++) {
      int c = tid + i * NTHR;
      int r = c >> 2, kc = (((c & 3) ^ ((0x1320 >> (r & 12)) & 3))) * 8;
      __builtin_amdgcn_global_load_lds((const unsigned*)(A + (size_t)(row0 + r) * lda + k0 + s * 32 + kc),
                                       (unsigned*)(st + s * 16384 + c * 16), 16, 0, 0);
      __builtin_amdgcn_global_load_lds((const unsigned*)(Bt + (size_t)(col0 + r) * ldb + k0 + s * 32 + kc),
                                       (unsigned*)(st + 32768 + s * 16384 + c * 16), 16, 0, 0);
    }
  }
}
__device__ __forceinline__ void gemm256_compute(const char* st, f32x4 (&acc)[8][4], int wr, int wc, int fr, int fq) {
  const int fqs = fq ^ ((0x1320 >> (fr & 12)) & 3);
#pragma unroll
  for (int s = 0; s < 2; s++) {
    bf16x8 b[4];
#pragma unroll
    for (int n = 0; n < 4; n++) b[n] = *(const bf16x8*)(st + 32768 + s * 16384 + ((wc * 64 + n * 16 + fr) * 32 + fqs * 8) * 2);
#pragma unroll
    for (int mh = 0; mh < 2; mh++) {
      bf16x8 a[4];
#pragma unroll
      for (int m = 0; m < 4; m++) a[m] = *(const bf16x8*)(st + s * 16384 + ((wr * 128 + mh * 64 + m * 16 + fr) * 32 + fqs * 8) * 2);
      __builtin_amdgcn_sched_barrier(0);
#pragma unroll
      for (int m = 0; m < 4; m++)
#pragma unroll
        for (int n = 0; n < 4; n++) acc[mh * 4 + m][n] = __builtin_amdgcn_mfma_f32_16x16x32_bf16(a[m], b[n], acc[mh * 4 + m][n], 0, 0, 0);
      __builtin_amdgcn_sched_barrier(0);
    }
  }
}
template <class Epi>
__device__ __forceinline__ void gemm_phase256(const bfr* A, int lda, const bfr* Bt, int ldb, int M, int N, int K, const Epi& epi,
                                              char* smem) {
  const int nM = M >> 8, nN = N >> 8, nk = K >> 6;
  const int tid = ftid(), wid = tid >> 6, lane = tid & 63;
  const int wr = wid >> 2, wc = wid & 3, fr = lane & 15, fq = lane >> 4;
  bool pre = false;
  for (int tile = blockIdx.x; tile < nM * nN; tile += gridDim.x) {
    int mt, nt;
    tile_map(tile, nM, nN, mt, nt);
    f32x4 acc[8][4];
#pragma unroll
    for (int m = 0; m < 8; m++)
#pragma unroll
      for (int n = 0; n < 4; n++) acc[m][n] = f32x4{0.f, 0.f, 0.f, 0.f};
    if (!pre) gemm256_stage(A, lda, Bt, ldb, mt * 256, nt * 256, 0, smem, tid);
#pragma unroll 1
    for (int kt = 0; kt < nk; kt++) {
      asm volatile("s_waitcnt vmcnt(0)" ::: "memory");
      __syncthreads();
      if (kt + 1 < nk) gemm256_stage(A, lda, Bt, ldb, mt * 256, nt * 256, (kt + 1) * 64, smem + ((kt + 1) & 1) * STAGE256, tid);
      gemm256_compute(smem + (kt & 1) * STAGE256, acc, wr, wc, fr, fq);
    }
    __syncthreads();
    pre = false;
    if (tile + (int)gridDim.x < nM * nN) {
      int mt2, nt2;
      tile_map(tile + (int)gridDim.x, nM, nN, mt2, nt2);
      gemm256_stage(A, lda, Bt, ldb, mt2 * 256, nt2 * 256, 0, smem, tid);
      pre = true;
    }
#pragma unroll
    for (int hh = 0; hh < 2; hh++) {
      f32x4 part[4][4];
#pragma unroll
      for (int m = 0; m < 4; m++)
#pragma unroll
        for (int n = 0; n < 4; n++) part[m][n] = acc[hh * 4 + m][n];
      epi(part, mt * 256 + wr * 128 + hh * 64, nt * 256 + wc * 64, fr, fq);
    }
  }
}

#define XB_TMO      128
#define XB_XCNT(j)  (256  + 64 * (j))
#define XB_XSUB(j)  (1280 + 64 * (j))
#define XB_XGEN(j)  (2304 + 64 * (j))
#define XB_TOP      3328
#define XB_TOPGEN   3392
#define XCD_BAR_WORDS 3456
#define XB_SPIN_CAP (1u << 18)
#define LAS __attribute__((address_space(3)))

__device__ __forceinline__ unsigned xb_ld(unsigned* p)              { return __hip_atomic_load(p, __ATOMIC_RELAXED, __HIP_MEMORY_SCOPE_AGENT); }
__device__ __forceinline__ unsigned xb_add(unsigned* p, unsigned v) { return __hip_atomic_fetch_add(p, v, __ATOMIC_RELAXED, __HIP_MEMORY_SCOPE_AGENT); }
__device__ __forceinline__ unsigned xb_xcc_id() { return (unsigned)__builtin_amdgcn_s_getreg((3 << 11) | 20) & 0xFu; }
#define XB_SPIN(cond, bar) do { unsigned _sp = 0; while (cond) { __builtin_amdgcn_s_sleep(1); \
    if ((++_sp & 255u) == 0u) { if (xb_ld(&(bar)[XB_TMO])) break; if (_sp > XB_SPIN_CAP) { atomicAdd(&(bar)[XB_TMO], 1u); break; } } } } while (0)

struct XcdBarrier {
    unsigned* bar; unsigned x;
    volatile LAS unsigned* st;
};

__device__ __forceinline__ XcdBarrier xcd_barrier_post(unsigned* bar, volatile LAS unsigned* st) {
    XcdBarrier b; b.bar = bar; b.x = xb_xcc_id(); b.st = st;
    if (threadIdx.x == 0) (void)xb_add(&bar[XB_XCNT(b.x)], 1u);
    return b;
}
__device__ __forceinline__ void xcd_barrier_complete(unsigned* bar, unsigned x, unsigned& nloc, unsigned& nx) {
    const unsigned G = gridDim.x * gridDim.y * gridDim.z;
    unsigned sum, cnt, mine, sp = 0u;
    for (;;) {
        sum = 0u; cnt = 0u; mine = 0u;
#pragma unroll
        for (unsigned j = 0; j < 16; ++j) { const unsigned c = xb_ld(&bar[XB_XCNT(j)]); sum += c; cnt += (c > 0u) ? 1u : 0u; mine = (j == x) ? c : mine; }
        if (sum == G) break;
        __builtin_amdgcn_s_sleep(1);
        if ((++sp & 255u) == 0u) { if (xb_ld(&bar[XB_TMO])) break; if (sp > XB_SPIN_CAP) { atomicAdd(&bar[XB_TMO], 1u); break; } }
    }
    nloc = mine > 0u ? mine : 1u; nx = cnt > 0u ? cnt : 1u;
}

__device__ __forceinline__ void xcd_barrier(const XcdBarrier& b) {
    asm volatile("s_waitcnt vmcnt(0)" ::: "memory");
    __syncthreads();
    if (threadIdx.x == 0) {
        unsigned* bar = b.bar;
        __builtin_amdgcn_s_waitcnt(0);
        unsigned nloc = b.st[0], nx = b.st[1];
        if (nloc == 0u) { xcd_barrier_complete(bar, b.x, nloc, nx); b.st[0] = nloc; b.st[1] = nx; }
        const unsigned old = xb_add(&bar[XB_XSUB(b.x)], 1u);
        const unsigned gen = old / nloc;
        if (old + 1u == (gen + 1u) * nloc) {
            __builtin_amdgcn_fence(__ATOMIC_RELEASE, "agent");
            asm volatile("s_waitcnt vmcnt(0)" ::: "memory");
            const unsigned og = xb_add(&bar[XB_TOP], 1u);
            const unsigned tg = og / nx;
            if (og + 1u == (tg + 1u) * nx) xb_add(&bar[XB_TOPGEN], 1u);
            else XB_SPIN(xb_ld(&bar[XB_TOPGEN]) == tg, bar);
            __builtin_amdgcn_fence(__ATOMIC_ACQUIRE, "agent");
            xb_add(&bar[XB_XGEN(b.x)], 1u);
            asm volatile("s_waitcnt vmcnt(0)" ::: "memory");
        } else {
            XB_SPIN(xb_ld(&bar[XB_XGEN(b.x)]) == gen, bar);
            __builtin_amdgcn_fence(__ATOMIC_ACQUIRE, "agent");
            asm volatile("s_waitcnt vmcnt(0)" ::: "memory");
        }
    }
    __syncthreads();
}


#define FRESH(Q) Pm Q = P0; asm volatile("" : "+s"(Q.ws))
__global__ void __launch_bounds__(NTHR) mega_kernel(Pm P0) {
  extern __shared__ __attribute__((aligned(16))) char smem[];
  cg::grid_group grid = cg::this_grid();
  unsigned* barw = (unsigned*)(P0.ws + OFF_BAR);
  if (blockIdx.x == 0) for (int i = threadIdx.x; i < XCD_BAR_WORDS; i += NTHR) barw[i] = 0u;
  if (threadIdx.x == 0) *(uint4*)(smem + 147456) = make_uint4(0u, 0u, 0u, 0u);
  grid.sync();
  XcdBarrier xb = xcd_barrier_post(barw, (volatile LAS unsigned*)(smem + 147456));

  for (int rep_ = 0; rep_ < ((REPEAT_MASK & 128) ? 2 : 1); rep_++) {
  { FRESH(P); phase_mod(P, smem); }
  { FRESH(P); convert_layer(P, 0, smem); }
  }
  xcd_barrier(xb);
  { FRESH(P); rowwise(P, 0, 0); }
  xcd_barrier(xb);

#pragma unroll 1
  for (int l = 0; l < DEPTH; l++) {
    for (int rep_ = 0; rep_ < ((REPEAT_MASK & 1) ? 2 : 1); rep_++) {
      { FRESH(P); gemm_phase256(WSP(bfr, OFF_A), 1024, WBF(W_RW), 1024, T, NRW + NGLA + NRET, 1024, EpiIn{P.ws, smem}, smem); }
    }
    xcd_barrier(xb);
    for (int rep_ = 0; rep_ < ((REPEAT_MASK & 64) ? 2 : 1); rep_++) { FRESH(P); rwkv_lerp(P, l); }
    { FRESH(P); ret_prep(P); }
    for (int rep_ = 0; rep_ < ((REPEAT_MASK & 64) ? 2 : 1); rep_++) { FRESH(P); gla_prep(P, l); }
    xcd_barrier(xb);
    {
      { FRESH(P); gemm_phase(WSP(bfr, OFF_SM) + 0, 320, WBF(W_L2F), 64, T, 1024, 64, EpiDecay{P.in[I_W0] + ((size_t)l * 2 + 0) * 1024, WSP(bfr, OFF_NEF), smem}, smem, 0, 0); }
      { FRESH(P); gemm_phase(WSP(bfr, OFF_SM) + 64, 320, WBF(W_L2B), 64, T, 1024, 64, EpiDecay{P.in[I_W0] + ((size_t)l * 2 + 1) * 1024, WSP(bfr, OFF_NEB), smem}, smem, 544, 0); }
      { FRESH(P); gemm_phase(WSP(bfr, OFF_SM) + 128, 320, WBF(W_LA2), 64, T, 1024, 64,
                 EpiA{P.in[I_A0] + (size_t)l * 1024, P.in[I_KK] + (size_t)l * 1024, P.in[I_KA] + (size_t)l * 1024, WSP(bfr, OFF_KP),
                      WSP(bfr, OFF_KKN), WSP(bfr, OFF_AA)}, smem, 1088, 0); }
      { FRESH(P); gemm_phase(WSP(bfr, OFF_SM) + 192, 320, WBF(W_LG2), 128, T, 1024, 128, EpiBf16{WSP(bfr, OFF_G), 1024, smem}, smem, 1632, 0); }
      if (l > 0) { FRESH(P); gemm_phase(WSP(bfr, OFF_V), 1024, WBF(W_LV1), 1024, T, 128, 1024, EpiBf16{WSP(bfr, OFF_U), 128, smem}, smem, 2176, 0); }
    }
    xcd_barrier(xb);
    if (l > 0) {
      { FRESH(P); gemm_phase(WSP(bfr, OFF_U), 128, WBF(W_LV2), 64, T, 1024, 64,
                 EpiVres{P.in[I_V0] + (size_t)(l - 1) * 1024, WSP(bfr, OFF_V), WSP(bfr, OFF_VF)}, smem, 0, 0); }
      xcd_barrier(xb);
    }
#pragma unroll 1
    for (int rep_ = 0; rep_ < ((REPEAT_MASK & 2) ? 2 : 1); rep_++)
#pragma unroll 1
    for (int u = blockIdx.x; u < 256; u += gridDim.x) {
      if (u < 128) { FRESH(P); if (SIMPLE_SCAN) rwkv_scan_simple(P, u); else rwkv_scan(P, u, smem); }
      else if (u < 192) { for (int r2_ = 0; r2_ < ((REPEAT_MASK & 16) ? 2 : 1); r2_++) { FRESH(P); chunk_scan<1>(P, l, u - 128, smem); } }
      else { for (int r2_ = 0; r2_ < ((REPEAT_MASK & 32) ? 2 : 1); r2_++) { FRESH(P); chunk_scan<2>(P, l, u - 192, smem); } }
    }
    xcd_barrier(xb);
    { FRESH(P); finish(P, l); }
    for (int rep_ = 0; rep_ < ((REPEAT_MASK & 4) ? 2 : 1); rep_++)
    { FRESH(P); gemm_phase256(WSP(bfr, OFF_A), 1024, WBF(W_GATE), 1024, T, NGATE, 1024, EpiSigmoid{WSP(bfr, OFF_PGATE), NGATE, smem}, smem); }
    xcd_barrier(xb);
    for (int rep_ = 0; rep_ < ((REPEAT_MASK & 4) ? 2 : 1); rep_++) {
    { FRESH(P); gemm_phase(WSP(bfr, OFF_OF), 1024, WBF(W_BR), 1024, T, 1024, 1024, EpiBranch{WSP(bfr, OFF_PGATE), WSP(bfr, OFF_MERGED), 0}, smem, 0, 0); }
    { FRESH(P); gemm_phase(WSP(bfr, OFF_OGLA), 1024, WBF(W_BR) + (size_t)1024 * 1024, 1024, T, 1024, 1024, EpiBranch{WSP(bfr, OFF_PGATE), WSP(bfr, OFF_MERGED), 1}, smem, 0, 0); }
    { FRESH(P); gemm_phase(WSP(bfr, OFF_ORET), 1024, WBF(W_BR) + (size_t)2 * 1024 * 1024, 1024, T, 1024, 1024, EpiBranch{WSP(bfr, OFF_PGATE), WSP(bfr, OFF_MERGED), 2}, smem, 0, 0); }
    }
    xcd_barrier(xb);
    for (int rep_ = 0; rep_ < ((REPEAT_MASK & 4) ? 2 : 1); rep_++)
    { FRESH(P); gemm_phase(WSP(bfr, OFF_MERGED), 1024, WBF(W_OUT), 1024, T, 1024, 1024, EpiF32{WSP(float, OFF_Y), 1024}, smem, 0, 0); }
    xcd_barrier(xb);
    { FRESH(P); rowwise(P, 1, l); }
    xcd_barrier(xb);
    for (int rep_ = 0; rep_ < ((REPEAT_MASK & 8) ? 2 : 1); rep_++)
    { FRESH(P); gemm_phase256(WSP(bfr, OFF_A), 1024, WBF(W_1), 1024, T, 4096, 1024, EpiRelu2{WSP(bfr, OFF_H), 4096, smem}, smem); }
    xcd_barrier(xb);
    for (int rep_ = 0; rep_ < ((REPEAT_MASK & 8) ? 2 : 1); rep_++)
    { FRESH(P); gemm_phase(WSP(bfr, OFF_H), 4096, WBF(W_2), 4096, T, 1024, 4096, EpiF32{WSP(float, OFF_Y), 1024}, smem, 0, 0); }
    xcd_barrier(xb);
    { FRESH(P); rowwise(P, 2, l); }
    for (int rep_ = 0; rep_ < ((REPEAT_MASK & 128) ? 2 : 1); rep_++) if (l + 1 < DEPTH) { FRESH(P); convert_layer(P, l + 1, smem); }
    xcd_barrier(xb);
  }
}

extern "C" void kernel_launch(void* const* d_in, const int* in_sizes, int n_in, void* d_out, int out_size, void* d_ws,
                              size_t ws_size, hipStream_t stream) {
  (void)in_sizes; (void)out_size;
  if (n_in < N_IN || ws_size < WS_NEED) {
    fprintf(stderr, "bad args: n_in %d ws %zu need %zu\n", n_in, ws_size, (size_t)WS_NEED);
    return;
  }
  static int grid_blocks = 0;
  if (!grid_blocks) {
    int dev = 0, cus = 0, per_cu = 0;
    hipGetDevice(&dev);
    hipDeviceGetAttribute(&cus, hipDeviceAttributeMultiprocessorCount, dev);
    hipFuncSetAttribute((const void*)mega_kernel, hipFuncAttributeMaxDynamicSharedMemorySize, SMEM_BYTES);
    hipOccupancyMaxActiveBlocksPerMultiprocessor(&per_cu, mega_kernel, NTHR, SMEM_BYTES);
    if (per_cu < 1) per_cu = 1;
    if (per_cu > 1) per_cu = 1;
    grid_blocks = cus * per_cu;
  }
  Pm p;
  memset(&p, 0, sizeof(p));
  for (int i = 0; i < N_IN; i++) p.in[i] = (const float*)d_in[i];
  p.out = (float*)d_out;
  p.ws = (char*)d_ws;
  void* args[] = {&p};
  hipError_t e = hipLaunchCooperativeKernel((void*)mega_kernel, dim3(grid_blocks), dim3(NTHR), args, SMEM_BYTES, stream);
  if (e != hipSuccess) fprintf(stderr, "cooperative launch failed: %s (grid %d)\n", hipGetErrorString(e), grid_blocks);
}
```

```cpp
#include <hip/hip_runtime.h>
#include <hip/hip_bf16.h>
#include <hip/hip_cooperative_groups.h>
#include <cstdio>
#include <cstdint>
#include <cstring>
namespace cg = cooperative_groups;

typedef unsigned short bfr;
using bf16x8 = __attribute__((ext_vector_type(8))) short;
using f32x4 = __attribute__((ext_vector_type(4))) float;
using u16x8 = __attribute__((ext_vector_type(8))) unsigned short;

constexpr int D = 1024, TC = 1024, TL = 16384, T = 17408, DEPTH = 4;
constexpr int NRW = 3584, NGLA = 3328, NRET = 4096, NGATE = 3072;
constexpr int D_IN = 13664;
constexpr int NTHR = 512;

enum { I_X = 0, I_C, I_CTX, I_CCTX, I_ADAW, I_ADAB, I_NPREMIX, I_NPOSTMIX, I_NPREMLP, I_NPOSTMLP, I_WIN, I_MU, I_W0,
       I_W2, I_A0, I_A2, I_G2, I_V0, I_V1, I_V2, I_KK, I_KA, I_RK, I_LNG, I_LNB, I_GA2, I_GAB, I_GNG, I_RDEC, I_RNG,
       I_WBR, I_WOUT, I_W1, I_W2M, N_IN };

constexpr size_t al256(size_t x) { return (x + 255) & ~size_t(255); }
constexpr size_t W_RW = 0;
constexpr size_t W_GLA = W_RW + (size_t)NRW * 1024;
constexpr size_t W_RET = W_GLA + (size_t)NGLA * 1024;
constexpr size_t W_GATE = W_RET + (size_t)NRET * 1024;
constexpr size_t W_BR = W_GATE + (size_t)NGATE * 1024;
constexpr size_t W_OUT = W_BR + (size_t)3 * 1024 * 1024;
constexpr size_t W_1 = W_OUT + (size_t)1024 * 1024;
constexpr size_t W_2 = W_1 + (size_t)4096 * 1024;
constexpr size_t W_L2F = W_2 + (size_t)4096 * 1024;
constexpr size_t W_L2B = W_L2F + 1024 * 64;
constexpr size_t W_LA2 = W_L2B + 1024 * 64;
constexpr size_t W_LG2 = W_LA2 + 1024 * 64;
constexpr size_t W_LV1 = W_LG2 + 1024 * 128;
constexpr size_t W_LV2 = W_LV1 + 128 * 1024;
constexpr size_t W_END = W_LV2 + 1024 * 64;

constexpr size_t SZ = (size_t)T * 1024 * 2;
constexpr size_t OFF_W = 0;
constexpr size_t OFF_XC = al256(W_END * 2);
constexpr size_t OFF_A = OFF_XC + (size_t)1024 * 1024 * 4;
constexpr size_t OFF_VF = OFF_A + SZ;
constexpr size_t OFF_MOD = OFF_VF + SZ;
constexpr size_t OFF_PRW = al256(OFF_MOD + (size_t)4 * 5 * 6144 * 4);
constexpr size_t OFF_PGLA = OFF_PRW + (size_t)T * NRW * 2;
constexpr size_t OFF_PRET = OFF_PGLA + (size_t)T * NGLA * 2;
constexpr size_t OFF_S7 = OFF_PRET + (size_t)T * NRET * 2;
constexpr size_t OFF_SM = OFF_S7 + 7 * SZ;
constexpr size_t OFF_U = OFF_SM + (size_t)T * 320 * 2;
constexpr size_t OFF_OGLA = OFF_U + (size_t)T * 128 * 2;
constexpr size_t OFF_ORET = OFF_OGLA + SZ;
constexpr size_t OFF_CUM = OFF_ORET + SZ;
constexpr size_t OFF_BAR = OFF_CUM + SZ;
constexpr size_t WS_NEED = OFF_BAR + 16384;
constexpr size_t OFF_OF = OFF_PRW, OFF_OB = OFF_PRW + SZ, OFF_G = OFF_PRW + 2 * SZ;
constexpr size_t OFF_MERGED = OFF_PGLA;
constexpr size_t OFF_Y = OFF_PRET;
constexpr size_t OFF_R = OFF_S7, OFF_KP = OFF_S7 + SZ, OFF_V = OFF_S7 + 2 * SZ, OFF_KKN = OFF_S7 + 3 * SZ,
                 OFF_AA = OFF_S7 + 4 * SZ, OFF_NEF = OFF_S7 + 5 * SZ, OFF_NEB = OFF_S7 + 6 * SZ;
constexpr size_t OFF_PGATE = OFF_S7 + 3 * SZ;
constexpr size_t OFF_H = OFF_S7;

constexpr int SMEM_BYTES = 147456 + 64;
#define SIMPLE_SCAN 0
#define REPEAT_MASK 0
#define ZERO_BRANCH 0


struct Pm {
  const float* in[N_IN];
  float* out;
  char* ws;
};

__device__ __forceinline__ bfr f2b(float f) {
  unsigned u = __float_as_uint(f);
  u += 0x7fffu + ((u >> 16) & 1u);
  return (bfr)(u >> 16);
}
__device__ __forceinline__ float b2f(bfr b) { return __uint_as_float(((unsigned)b) << 16); }
__device__ __forceinline__ float sigmoidf_(float x) { return __builtin_amdgcn_rcpf(1.0f + __expf(-x)); }
__device__ __forceinline__ float siluf_(float x) { return x * sigmoidf_(x); }
__device__ __forceinline__ float wave_sum(float x) {
#pragma unroll
  for (int o = 32; o >= 1; o >>= 1) x += __shfl_xor(x, o);
  return x;
}
__device__ __forceinline__ int ftid() {
  int t = threadIdx.x;
  asm volatile("" : "+v"(t));
  return t;
}
#define WSP(T_, off) ((T_*)(P.ws + (off)))
#define WBF(off) ((bfr*)(P.ws + OFF_W) + (off))

__device__ __forceinline__ void conv_T(const float* __restrict__ src, int ld, int Ksrc, int Kdst, int nvalid, int npad, bfr* __restrict__ dst,
                       char* smem) {
  float* tile = (float*)smem;
  const int tid = ftid();
  const int nk = Kdst / 64, nn = npad / 64;
  for (int t = blockIdx.x; t < nk * nn; t += gridDim.x) {
    const int kt = t % nk, nt = t / nk;
    const int k0 = kt * 64, n0 = nt * 64;
#pragma unroll
    for (int i = 0; i < 2; i++) {
      const int e = tid + i * NTHR;
      const int kk = e >> 4, nq = (e & 15) * 4;
      float4 v = make_float4(0.f, 0.f, 0.f, 0.f);
      if (k0 + kk < Ksrc && n0 + nq < nvalid) v = *(const float4*)(src + (size_t)(k0 + kk) * ld + n0 + nq);
      float* tp = tile + kk * 65 + nq;
      tp[0] = v.x; tp[1] = v.y; tp[2] = v.z; tp[3] = v.w;
    }
    __syncthreads();
    {
      const int n = tid >> 3, kc = (tid & 7) * 8;
      u16x8 o;
#pragma unroll
      for (int i = 0; i < 8; i++) o[i] = f2b(tile[(kc + i) * 65 + n]);
      *(u16x8*)(dst + (size_t)(n0 + n) * Kdst + k0 + kc) = o;
    }
    __syncthreads();
  }
}

__device__ __forceinline__ void convert_layer(const Pm& P, int l, char* smem) {
  const float* win = P.in[I_WIN] + (size_t)l * 1024 * D_IN;
  conv_T(win + 0, D_IN, 1024, 1024, 3392, NRW, WBF(W_RW), smem);
  conv_T(win + 3392, D_IN, 1024, 1024, 3104, NGLA, WBF(W_GLA), smem);
  conv_T(win + 6496, D_IN, 1024, 1024, 4096, NRET, WBF(W_RET), smem);
  conv_T(win + 10592, D_IN, 1024, 1024, 3072, NGATE, WBF(W_GATE), smem);
  for (int i = 0; i < 3; i++)
    conv_T(P.in[I_WBR] + ((size_t)l * 3 + i) * 1024 * 1024, 1024, 1024, 1024, 1024, 1024, WBF(W_BR) + (size_t)i * 1024 * 1024,
           smem);
  conv_T(P.in[I_WOUT] + (size_t)l * 1024 * 1024, 1024, 1024, 1024, 1024, 1024, WBF(W_OUT), smem);
  conv_T(P.in[I_W1] + (size_t)l * 1024 * 4096, 4096, 1024, 1024, 4096, 4096, WBF(W_1), smem);
  conv_T(P.in[I_W2M] + (size_t)l * 4096 * 1024, 1024, 4096, 4096, 1024, 1024, WBF(W_2), smem);
  conv_T(P.in[I_W2] + ((size_t)l * 2 + 0) * 64 * 1024, 1024, 64, 64, 1024, 1024, WBF(W_L2F), smem);
  conv_T(P.in[I_W2] + ((size_t)l * 2 + 1) * 64 * 1024, 1024, 64, 64, 1024, 1024, WBF(W_L2B), smem);
  conv_T(P.in[I_A2] + (size_t)l * 64 * 1024, 1024, 64, 64, 1024, 1024, WBF(W_LA2), smem);
  conv_T(P.in[I_G2] + (size_t)l * 128 * 1024, 1024, 128, 128, 1024, 1024, WBF(W_LG2), smem);
  if (l > 0) {
    conv_T(P.in[I_V1] + (size_t)(l - 1) * 1024 * 32, 32, 1024, 1024, 32, 128, WBF(W_LV1), smem);
    conv_T(P.in[I_V2] + (size_t)(l - 1) * 32 * 1024, 1024, 32, 64, 1024, 1024, WBF(W_LV2), smem);
  }
}

__device__ __forceinline__ void phase_mod(const Pm& P, char* smem) {
  float* sc = (float*)smem;
  float* red = (float*)smem + 5 * 1024;
  const int tid = ftid();
  for (int e = tid; e < 5 * 1024; e += NTHR) {
    int r = e >> 10, k = e & 1023;
    float v = (r < 4) ? P.in[I_C][r * 1024 + k] : P.in[I_CCTX][k];
    sc[e] = siluf_(v);
  }
  __syncthreads();
  float* MODV = WSP(float, OFF_MOD);
  for (int item = blockIdx.x; item < 4 * 48; item += gridDim.x) {
    const int l = item / 48, cb = item % 48;
    const int col = cb * 128 + (tid & 127), kq = tid >> 7;
    const float* w = P.in[I_ADAW] + (size_t)l * 1024 * 6144 + col;
    float acc[5] = {0, 0, 0, 0, 0};
#pragma unroll 16
    for (int k = kq * 256; k < kq * 256 + 256; k++) {
      float wv = w[(size_t)k * 6144];
#pragma unroll
      for (int r = 0; r < 5; r++) acc[r] += sc[r * 1024 + k] * wv;
    }
#pragma unroll
    for (int r = 0; r < 5; r++) red[(kq * 5 + r) * 128 + (tid & 127)] = acc[r];
    __syncthreads();
    if (kq == 0) {
      float bias = P.in[I_ADAB][(size_t)l * 6144 + col];
#pragma unroll
      for (int r = 0; r < 5; r++) {
        float s = red[(0 * 5 + r) * 128 + tid] + red[(1 * 5 + r) * 128 + tid] + red[(2 * 5 + r) * 128 + tid] +
                  red[(3 * 5 + r) * 128 + tid];
        MODV[((size_t)l * 5 + r) * 6144 + col] = s + bias;
      }
    }
    __syncthreads();
  }
}

__device__ __forceinline__ void rowwise(const Pm& P, int mode, int l) {
  const int tid_ = ftid();
  const int lane = tid_ & 63, wid = tid_ >> 6;
  const float* MODV = WSP(float, OFF_MOD);
  const float* Y = WSP(float, OFF_Y);
  bfr* A = WSP(bfr, OFF_A);
  for (int row = blockIdx.x * 8 + wid; row < T; row += gridDim.x * 8) {
    float* xr = (row < TC) ? (WSP(float, OFF_XC) + (size_t)row * 1024) : (P.out + (size_t)(row - TC) * 1024);
    const int mrow = (row < TC) ? 4 : ((row - TC) >> 12);
    const float* md = MODV + ((size_t)l * 5 + mrow) * 6144;
    const int c0 = lane * 16;
    float x[16];
    const float* xsrc = xr;
    if (mode == 0) xsrc = (row < TC) ? (P.in[I_CTX] + (size_t)row * 1024) : (P.in[I_X] + (size_t)(row - TC) * 1024);
#pragma unroll
    for (int i = 0; i < 4; i++) {
      float4 v = *(const float4*)(xsrc + c0 + i * 4);
      x[i * 4 + 0] = v.x; x[i * 4 + 1] = v.y; x[i * 4 + 2] = v.z; x[i * 4 + 3] = v.w;
    }
    if (mode != 0) {
      float y[16];
      float ss = 0.f;
#pragma unroll
      for (int i = 0; i < 4; i++) {
        float4 v = *(const float4*)(Y + (size_t)row * 1024 + c0 + i * 4);
        y[i * 4 + 0] = v.x; y[i * 4 + 1] = v.y; y[i * 4 + 2] = v.z; y[i * 4 + 3] = v.w;
      }
#pragma unroll
      for (int i = 0; i < 16; i++) ss += y[i] * y[i];
      ss = wave_sum(ss);
      const float rs = rsqrtf(ss * (1.0f / 1024.0f) + 1e-6f);
      const float* gate = md + (mode == 1 ? 2 : 5) * 1024 + c0;
      const float* gp = P.in[mode == 1 ? I_NPOSTMIX : I_NPOSTMLP] + (size_t)l * 1024 + c0;
#pragma unroll
      for (int i = 0; i < 16; i++) x[i] += gate[i] * (y[i] * rs * gp[i]);
    }
    if (mode != 2 || true) {
#pragma unroll
      for (int i = 0; i < 4; i++) *(float4*)(xr + c0 + i * 4) = make_float4(x[i * 4], x[i * 4 + 1], x[i * 4 + 2], x[i * 4 + 3]);
    }
    if (mode == 2 && l + 1 >= DEPTH) continue;
    float ss2 = 0.f;
#pragma unroll
    for (int i = 0; i < 16; i++) ss2 += x[i] * x[i];
    ss2 = wave_sum(ss2);
    const float rs2 = rsqrtf(ss2 * (1.0f / 1024.0f) + 1e-6f);
    const float *gpre, *shift, *scale;
    if (mode == 0) {
      gpre = P.in[I_NPREMIX] + c0; shift = md + c0; scale = md + 1024 + c0;
    } else if (mode == 1) {
      gpre = P.in[I_NPREMLP] + (size_t)l * 1024 + c0; shift = md + 3 * 1024 + c0; scale = md + 4 * 1024 + c0;
    } else {
      const float* md2 = MODV + ((size_t)(l + 1) * 5 + mrow) * 6144;
      gpre = P.in[I_NPREMIX] + (size_t)(l + 1) * 1024 + c0; shift = md2 + c0; scale = md2 + 1024 + c0;
    }
    u16x8 o0, o1;
#pragma unroll
    for (int i = 0; i < 8; i++) {
      o0[i] = f2b((x[i] * rs2 * gpre[i]) * (1.0f + scale[i]) + shift[i]);
      o1[i] = f2b((x[i + 8] * rs2 * gpre[i + 8]) * (1.0f + scale[i + 8]) + shift[i + 8]);
    }
    *(u16x8*)(A + (size_t)row * 1024 + c0) = o0;
    *(u16x8*)(A + (size_t)row * 1024 + c0 + 8) = o1;
  }
}

constexpr int STAGE_BYTES = 49152;
__device__ __forceinline__ void gemm_stage(const bfr* __restrict__ A, int lda, const bfr* __restrict__ Bt, int ldb, int row0,
                                           int col0, int k0, char* st, int tid) {
#pragma unroll
  for (int s = 0; s < 2; s++) {
#pragma unroll
    for (int i = 0; i < 2; i++) {
      int c = tid + i * NTHR;
      int r = c >> 2, kc = (((c & 3) ^ ((0x1320 >> (r & 12)) & 3))) * 8;
      __builtin_amdgcn_global_load_lds((const unsigned*)(A + (size_t)(row0 + r) * lda + k0 + s * 32 + kc),
                                       (unsigned*)(st + s * 16384 + c * 16), 16, 0, 0);
    }
    {
      int c = tid;
      int r = c >> 2, kc = (((c & 3) ^ ((0x1320 >> (r & 12)) & 3))) * 8;
      __builtin_amdgcn_global_load_lds((const unsigned*)(Bt + (size_t)(col0 + r) * ldb + k0 + s * 32 + kc),
                                       (unsigned*)(st + 32768 + s * 8192 + c * 16), 16, 0, 0);
    }
  }
}
struct Frags { bf16x8 a[2][4], b[2][4]; };
__device__ __forceinline__ void gemm_load_frags(const char* st, Frags& f, int wr, int wc, int fr, int fq) {
  const int fqs = fq ^ ((0x1320 >> (fr & 12)) & 3);
#pragma unroll
  for (int s = 0; s < 2; s++) {
#pragma unroll
    for (int m = 0; m < 4; m++) f.a[s][m] = *(const bf16x8*)(st + s * 16384 + ((wr * 64 + m * 16 + fr) * 32 + fqs * 8) * 2);
#pragma unroll
    for (int n = 0; n < 4; n++) f.b[s][n] = *(const bf16x8*)(st + 32768 + s * 8192 + ((wc * 64 + n * 16 + fr) * 32 + fqs * 8) * 2);
  }
}
__device__ __forceinline__ void gemm_mfma(const Frags& f, f32x4 (&acc)[4][4]) {
#pragma unroll
  for (int s = 0; s < 2; s++) {
#pragma unroll
    for (int m = 0; m < 4; m++)
#pragma unroll
      for (int n = 0; n < 4; n++) acc[m][n] = __builtin_amdgcn_mfma_f32_16x16x32_bf16(f.a[s][m], f.b[s][n], acc[m][n], 0, 0, 0);
  }
}
__device__ __forceinline__ void gemm_kloop(const bfr* __restrict__ A, int lda, const bfr* __restrict__ Bt, int ldb, int row0,
                                           int col0, int K, char* smem, f32x4 (&acc)[4][4], int tid, bool pre) {
  const int wid = tid >> 6, lane = tid & 63;
  const int wr = wid >> 1, wc = wid & 1, fr = lane & 15, fq = lane >> 4;
  const int nk = K >> 6;
  const bool grpY = wid >= 4;
  if (!pre) {
    gemm_stage(A, lda, Bt, ldb, row0, col0, 0, smem, tid);
    if (nk > 1) gemm_stage(A, lda, Bt, ldb, row0, col0, 64, smem + STAGE_BYTES, tid);
  }
  Frags F;
#pragma unroll
  for (int s = 0; s < 2; s++)
#pragma unroll
    for (int m = 0; m < 4; m++) { F.a[s][m] = bf16x8{0, 0, 0, 0, 0, 0, 0, 0}; F.b[s][m] = bf16x8{0, 0, 0, 0, 0, 0, 0, 0}; }
  int cur = 0, nxt = 2;
  for (int kt = 0; kt < nk; kt++) {
    if (kt + 1 < nk) asm volatile("s_waitcnt vmcnt(6)" ::: "memory");
    else asm volatile("s_waitcnt vmcnt(0)" ::: "memory");
    __syncthreads();
    if (kt + 2 < nk) gemm_stage(A, lda, Bt, ldb, row0, col0, (kt + 2) * 64, smem + nxt * STAGE_BYTES, tid);
    if (grpY) gemm_mfma(F, acc);
    __builtin_amdgcn_sched_barrier(0);
    gemm_load_frags(smem + cur * STAGE_BYTES, F, wr, wc, fr, fq);
    __builtin_amdgcn_sched_barrier(0);
    if (!grpY) gemm_mfma(F, acc);
    cur = (cur == 2) ? 0 : cur + 1;
    nxt = (nxt == 2) ? 0 : nxt + 1;
  }
  if (grpY) gemm_mfma(F, acc);
  __syncthreads();
}
__device__ __forceinline__ void tile_map(int tile, int nM, int nN, int& mt, int& nt) {
  const int WGM = 16;
  int nig = WGM * nN, gid = tile / nig, fm = gid * WGM;
  int gs = min(nM - fm, WGM);
  mt = fm + (tile % nig) % gs;
  nt = (tile % nig) / gs;
}

template <class Epi>
__device__ __forceinline__ void gemm_phase(const bfr* A, int lda, const bfr* Bt, int ldb, int M, int N, int K, const Epi& epi, char* smem,
                           int tile_off, int tile_total) {
  const int nM = M >> 8, nN = N >> 7;
  const int tid = ftid(), wid = tid >> 6, lane = tid & 63;
  const int wr = wid >> 1, wc = wid & 1, fr = lane & 15, fq = lane >> 4;
  int first = blockIdx.x;
  int g0 = tile_off;
  int start = ((first - (g0 % (int)gridDim.x)) % (int)gridDim.x + (int)gridDim.x) % (int)gridDim.x;
  bool pre = false;
  for (int tile = start; tile < nM * nN; tile += gridDim.x) {
    int mt, nt;
    tile_map(tile, nM, nN, mt, nt);
    f32x4 acc[4][4];
#pragma unroll
    for (int m = 0; m < 4; m++)
#pragma unroll
      for (int n = 0; n < 4; n++) acc[m][n] = f32x4{0.f, 0.f, 0.f, 0.f};
    gemm_kloop(A, lda, Bt, ldb, mt * 256, nt * 128, K, smem, acc, tid, pre);
    pre = false;
    if (tile + (int)gridDim.x < nM * nN) {
      int mt2, nt2;
      tile_map(tile + (int)gridDim.x, nM, nN, mt2, nt2);
      gemm_stage(A, lda, Bt, ldb, mt2 * 256, nt2 * 128, 0, smem, tid);
      if (K > 64) gemm_stage(A, lda, Bt, ldb, mt2 * 256, nt2 * 128, 64, smem + STAGE_BYTES, tid);
      pre = true;
    }
    epi(acc, mt * 256 + wr * 64, nt * 128 + wc * 64, fr, fq);
  }
  (void)tile_total;
}

template <class F>
__device__ __forceinline__ void wave_store_bf16(f32x4 (&acc)[4][4], const F& f, bfr* C, int ldc, int rb, int cb, int fr, int fq,
                                                char* sm) {
  const int tid_ = threadIdx.x;
  const int lane = tid_ & 63;
  bfr* sc = (bfr*)(sm + 2 * STAGE_BYTES + (tid_ >> 6) * 6144);
#pragma unroll
  for (int half = 0; half < 2; half++) {
#pragma unroll
    for (int mm = 0; mm < 2; mm++)
#pragma unroll
      for (int n = 0; n < 4; n++)
#pragma unroll
        for (int j = 0; j < 4; j++)
          sc[(mm * 16 + fq * 4 + j) * 72 + n * 16 + fr] = f2b(f(acc[half * 2 + mm][n][j], cb + n * 16 + fr));
    __builtin_amdgcn_fence(__ATOMIC_RELEASE, "wavefront");
    __builtin_amdgcn_wave_barrier();
    __builtin_amdgcn_fence(__ATOMIC_ACQUIRE, "wavefront");
#pragma unroll
    for (int it = 0; it < 4; it++) {
      const int id = it * 64 + lane;
      const int rl = id >> 3, ch = id & 7;
      u16x8 v = *(const u16x8*)(sc + rl * 72 + ch * 8);
      *(u16x8*)(C + (size_t)(rb + half * 32 + rl) * ldc + cb + ch * 8) = v;
    }
    __builtin_amdgcn_fence(__ATOMIC_RELEASE, "wavefront");
    __builtin_amdgcn_wave_barrier();
    __builtin_amdgcn_fence(__ATOMIC_ACQUIRE, "wavefront");
  }
}
struct EpiBf16 {
  bfr* C; int ldc; char* sm;
  __device__ __forceinline__ void operator()(f32x4 (&acc)[4][4], int rb, int cb, int fr, int fq) const {
    wave_store_bf16(acc, [](float v, int) { return v; }, C, ldc, rb, cb, fr, fq, sm);
  }
};
struct EpiIn {
  char* ws; char* sm;
  __device__ __forceinline__ void operator()(f32x4 (&acc)[4][4], int rb, int cb, int fr, int fq) const {
    const int seg = (cb >= NRW) + (cb >= NRW + NGLA);
    const size_t off = (seg == 0) ? OFF_PRW : ((seg == 1) ? OFF_PGLA : OFF_PRET);
    const int ldc = (seg == 0) ? NRW : ((seg == 1) ? NGLA : NRET);
    const int c0 = cb - ((seg == 0) ? 0 : ((seg == 1) ? NRW : NRW + NGLA));
    wave_store_bf16(acc, [](float v, int) { return v; }, (bfr*)(ws + off), ldc, rb, c0, fr, fq, sm);
  }
};
struct EpiF32 {
  float* C; int ldc;
  __device__ __forceinline__ void operator()(f32x4 (&acc)[4][4], int rb, int cb, int fr, int fq) const {
#pragma unroll
    for (int m = 0; m < 4; m++)
#pragma unroll
      for (int n = 0; n < 4; n++)
#pragma unroll
        for (int j = 0; j < 4; j++) C[(size_t)(rb + m * 16 + fq * 4 + j) * ldc + cb + n * 16 + fr] = acc[m][n][j];
  }
};
struct EpiRelu2 {
  bfr* C; int ldc; char* sm;
  __device__ __forceinline__ void operator()(f32x4 (&acc)[4][4], int rb, int cb, int fr, int fq) const {
    wave_store_bf16(acc, [](float v, int) { float r = fmaxf(v, 0.f); return r * r; }, C, ldc, rb, cb, fr, fq, sm);
  }
};
struct EpiSigmoid {
  bfr* C; int ldc; char* sm;
  __device__ __forceinline__ void operator()(f32x4 (&acc)[4][4], int rb, int cb, int fr, int fq) const {
    wave_store_bf16(acc, [](float v, int) { return sigmoidf_(v); }, C, ldc, rb, cb, fr, fq, sm);
  }
};
struct EpiDecay {
  const float* w0; bfr* C; char* sm;
  __device__ __forceinline__ void operator()(f32x4 (&acc)[4][4], int rb, int cb, int fr, int fq) const {
    const float* w0_ = w0;
    wave_store_bf16(acc, [w0_](float v, int col) {
      float x = w0_[col] + v;
      float lw = -0.6065306597126334f * sigmoidf_(x);
      return __expf(lw) - 1.0f;
    }, C, 1024, rb, cb, fr, fq, sm);
  }
};
struct EpiA {
  const float *a0, *k_k, *k_a;
  bfr *KP, *KKN, *AA;
  __device__ __forceinline__ void operator()(f32x4 (&acc)[4][4], int rb, int cb, int fr, int fq) const {
    float a0c[4], kkc[4], kac[4];
#pragma unroll
    for (int n = 0; n < 4; n++) {
      int col = cb + n * 16 + fr;
      a0c[n] = a0[col]; kkc[n] = k_k[col]; kac[n] = k_a[col];
    }
#pragma unroll
    for (int m = 0; m < 4; m++)
#pragma unroll
      for (int j = 0; j < 4; j++) {
        const size_t rowoff = (size_t)(rb + m * 16 + fq * 4 + j) * 1024;
        float k0[4], kr[4], av[4];
        float ss = 0.f;
#pragma unroll
        for (int n = 0; n < 4; n++) {
          int col = cb + n * 16 + fr;
          k0[n] = b2f(KP[rowoff + col]);
          kr[n] = k0[n] * kkc[n];
          ss += kr[n] * kr[n];
          av[n] = sigmoidf_(a0c[n] + acc[m][n][j]);
        }
        ss += __shfl_xor(ss, 1); ss += __shfl_xor(ss, 2); ss += __shfl_xor(ss, 4); ss += __shfl_xor(ss, 8);
        const float rn = rsqrtf(fmaxf(ss, 1e-12f));
#pragma unroll
        for (int n = 0; n < 4; n++) {
          int col = cb + n * 16 + fr;
          KKN[rowoff + col] = f2b(kr[n] * rn);
          AA[rowoff + col] = f2b(-(kr[n] * rn) * av[n]);
          KP[rowoff + col] = f2b(k0[n] * (1.0f + (av[n] - 1.0f) * kac[n]));
        }
      }
  }
};
struct EpiVres {
  const float* v0b; bfr* V; const bfr* VF;
  __device__ __forceinline__ void operator()(f32x4 (&acc)[4][4], int rb, int cb, int fr, int fq) const {
#pragma unroll
    for (int n = 0; n < 4; n++) {
      const int col = cb + n * 16 + fr;
      const float bc = v0b[col];
#pragma unroll
      for (int m = 0; m < 4; m++)
#pragma unroll
        for (int j = 0; j < 4; j++) {
          size_t idx = (size_t)(rb + m * 16 + fq * 4 + j) * 1024 + col;
          float v0 = b2f(V[idx]), vf = b2f(VF[idx]);
          V[idx] = f2b(v0 + (vf - v0) * sigmoidf_(bc + acc[m][n][j]));
        }
    }
  }
};

struct EpiBranch {
  const bfr* PG; bfr* MG; int i;
  __device__ __forceinline__ void operator()(f32x4 (&acc)[4][4], int rb, int cb, int fr, int fq) const {
#pragma unroll
    for (int n = 0; n < 4; n++) {
      const int col = cb + n * 16 + fr;
#pragma unroll
      for (int m = 0; m < 4; m++)
#pragma unroll
        for (int j = 0; j < 4; j++) {
          const size_t r_ = (size_t)(rb + m * 16 + fq * 4 + j);
          float v = b2f(PG[r_ * NGATE + i * 1024 + col]) * acc[m][n][j];
          if (i > 0) v += b2f(MG[r_ * 1024 + col]);
          MG[r_ * 1024 + col] = f2b(v);
        }
    }
  }
};

__device__ __forceinline__ void rwkv_lerp(const Pm& P, int l) {
  const bfr* PR = WSP(bfr, OFF_PRW);
  const float* mu = P.in[I_MU] + (size_t)l * 3392;
  bfr* R = WSP(bfr, OFF_R); bfr* KP = WSP(bfr, OFF_KP); bfr* V = WSP(bfr, OFF_V); bfr* VF = WSP(bfr, OFF_VF);
  bfr* SM = WSP(bfr, OFF_SM);
  const long nitems = (long)T * 424;
  for (long it = (long)blockIdx.x * NTHR + ftid(); it < nitems; it += (long)gridDim.x * NTHR) {
    const int row = (int)(it / 424), j = (int)(it % 424);
    const int c0 = j * 8;
    const bfr* pr = PR + (size_t)row * NRW + c0;
    u16x8 p = *(const u16x8*)pr;
    u16x8 nb[4];
    const u16x8 zero = {0, 0, 0, 0, 0, 0, 0, 0};
    if (row < TC) {
      const int t = row & 255;
      nb[0] = (t > 0) ? *(const u16x8*)(pr - NRW) : zero;
      nb[1] = (t < 255) ? *(const u16x8*)(pr + NRW) : zero;
      nb[2] = nb[0]; nb[3] = nb[1];
    } else {
      const int t = (row - TC) & 4095;
      const int gx = t & 63, gy = t >> 6;
      nb[0] = (gx > 0) ? *(const u16x8*)(pr - NRW) : zero;
      nb[1] = (gx < 63) ? *(const u16x8*)(pr + NRW) : zero;
      nb[2] = (gy > 0) ? *(const u16x8*)(pr - (size_t)64 * NRW) : zero;
      nb[3] = (gy < 63) ? *(const u16x8*)(pr + (size_t)64 * NRW) : zero;
    }
    float o[8];
#pragma unroll
    for (int e = 0; e < 8; e++) {
      float pv = b2f(p[e]);
      float sv = b2f(nb[e & 3][e]);
      o[e] = pv + (sv - pv) * mu[c0 + e];
    }
    u16x8 ov;
    if (c0 < 3072) {
#pragma unroll
      for (int e = 0; e < 8; e++) ov[e] = f2b(o[e]);
      const int seg = c0 >> 10, cc = c0 & 1023;
      bfr* dst = (seg == 0) ? R : (seg == 1 ? KP : V);
      *(u16x8*)(dst + (size_t)row * 1024 + cc) = ov;
      if (seg == 2 && l == 0) *(u16x8*)(VF + (size_t)row * 1024 + cc) = ov;
    } else {
      const int cs = c0 - 3072;
#pragma unroll
      for (int e = 0; e < 8; e++) {
        float v = o[e];
        if (cs < 128) v = 1.0f - 2.0f * __builtin_amdgcn_rcpf(1.0f + __expf(2.0f * v));
        else if (cs >= 192) v = sigmoidf_(v);
        ov[e] = f2b(v);
      }
      *(u16x8*)(SM + (size_t)row * 320 + cs) = ov;
    }
  }
}

__device__ __forceinline__ void ret_prep(const Pm& P) {
  bfr* PT = WSP(bfr, OFF_PRET);
  const long nitems = (long)T * 64;
  for (long it = (long)blockIdx.x * NTHR + ftid(); it < nitems; it += (long)gridDim.x * NTHR) {
    const int row = (int)(it >> 6), rem = (int)(it & 63);
    const int h = rem >> 4, i0 = (rem & 15) * 8;
    const float pos = (row < TC) ? (float)(row & 255) : (float)(256 + ((row - TC) & 4095));
    float cs[8], sn[8];
#pragma unroll
    for (int e = 0; e < 8; e++) {
      float invf = exp2f(-(float)(i0 + e) * (13.287712379549449f / 128.0f));
      float ang = pos * invf;
      sincosf(ang, &sn[e], &cs[e]);
    }
#pragma unroll
    for (int qk = 0; qk < 2; qk++) {
      bfr* base = PT + (size_t)row * NRET + qk * 1024 + h * 256 + i0;
      u16x8 t1 = *(u16x8*)base, t2 = *(u16x8*)(base + 128);
      const float scl = qk ? 0.0625f : 1.0f;
      u16x8 o1, o2;
#pragma unroll
      for (int e = 0; e < 8; e++) {
        float a = b2f(t1[e]), b = b2f(t2[e]);
        o1[e] = f2b((a * cs[e] - b * sn[e]) * scl);
        o2[e] = f2b((a * sn[e] + b * cs[e]) * scl);
      }
      *(u16x8*)base = o1;
      *(u16x8*)(base + 128) = o2;
    }
  }
}

#define FMAC_BC(acc, x, s, J) \
  asm("v_fmac_f32_dpp %0, %1, %2 row_newbcast:" #J " row_mask:0xf bank_mask:0xf" : "+v"(acc) : "v"(x), "v"(s))
#define DOT16(o0_, o1_, o2_, o3_, x_) asm("v_mul_f32_dpp %0, %4, %5 row_newbcast:0 row_mask:0xf bank_mask:0xf\n\t" \
  "v_mul_f32_dpp %1, %4, %6 row_newbcast:1 row_mask:0xf bank_mask:0xf\n\t" \
  "v_mul_f32_dpp %2, %4, %7 row_newbcast:2 row_mask:0xf bank_mask:0xf\n\t" \
  "v_mul_f32_dpp %3, %4, %8 row_newbcast:3 row_mask:0xf bank_mask:0xf\n\t" \
  "v_fmac_f32_dpp %0, %4, %9 row_newbcast:4 row_mask:0xf bank_mask:0xf\n\t" \
  "v_fmac_f32_dpp %1, %4, %10 row_newbcast:5 row_mask:0xf bank_mask:0xf\n\t" \
  "v_fmac_f32_dpp %2, %4, %11 row_newbcast:6 row_mask:0xf bank_mask:0xf\n\t" \
  "v_fmac_f32_dpp %3, %4, %12 row_newbcast:7 row_mask:0xf bank_mask:0xf\n\t" \
  "v_fmac_f32_dpp %0, %4, %13 row_newbcast:8 row_mask:0xf bank_mask:0xf\n\t" \
  "v_fmac_f32_dpp %1, %4, %14 row_newbcast:9 row_mask:0xf bank_mask:0xf\n\t" \
  "v_fmac_f32_dpp %2, %4, %15 row_newbcast:10 row_mask:0xf bank_mask:0xf\n\t" \
  "v_fmac_f32_dpp %3, %4, %16 row_newbcast:11 row_mask:0xf bank_mask:0xf\n\t" \
  "v_fmac_f32_dpp %0, %4, %17 row_newbcast:12 row_mask:0xf bank_mask:0xf\n\t" \
  "v_fmac_f32_dpp %1, %4, %18 row_newbcast:13 row_mask:0xf bank_mask:0xf\n\t" \
  "v_fmac_f32_dpp %2, %4, %19 row_newbcast:14 row_mask:0xf bank_mask:0xf\n\t" \
  "v_fmac_f32_dpp %3, %4, %20 row_newbcast:15 row_mask:0xf bank_mask:0xf\n\t" \
  : "=&v"(o0_), "=&v"(o1_), "=&v"(o2_), "=&v"(o3_) \
  : "v"(x_), "v"(S[0]), "v"(S[1]), "v"(S[2]), "v"(S[3]), "v"(S[4]), "v"(S[5]), "v"(S[6]), "v"(S[7]), "v"(S[8]), "v"(S[9]), "v"(S[10]), "v"(S[11]), "v"(S[12]), "v"(S[13]), "v"(S[14]), "v"(S[15]))
#define UPD_A(ne_, kp_, vv_) asm("v_fmac_f32_dpp %0, %16, %0 row_newbcast:0 row_mask:0xf bank_mask:0xf\n\t" \
  "v_fmac_f32_dpp %1, %16, %1 row_newbcast:1 row_mask:0xf bank_mask:0xf\n\t" \
  "v_fmac_f32_dpp %2, %16, %2 row_newbcast:2 row_mask:0xf bank_mask:0xf\n\t" \
  "v_fmac_f32_dpp %3, %16, %3 row_newbcast:3 row_mask:0xf bank_mask:0xf\n\t" \
  "v_fmac_f32_dpp %4, %16, %4 row_newbcast:4 row_mask:0xf bank_mask:0xf\n\t" \
  "v_fmac_f32_dpp %5, %16, %5 row_newbcast:5 row_mask:0xf bank_mask:0xf\n\t" \
  "v_fmac_f32_dpp %6, %16, %6 row_newbcast:6 row_mask:0xf bank_mask:0xf\n\t" \
  "v_fmac_f32_dpp %7, %16, %7 row_newbcast:7 row_mask:0xf bank_mask:0xf\n\t" \
  "v_fmac_f32_dpp %8, %16, %8 row_newbcast:8 row_mask:0xf bank_mask:0xf\n\t" \
  "v_fmac_f32_dpp %9, %16, %9 row_newbcast:9 row_mask:0xf bank_mask:0xf\n\t" \
  "v_fmac_f32_dpp %10, %16, %10 row_newbcast:10 row_mask:0xf bank_mask:0xf\n\t" \
  "v_fmac_f32_dpp %11, %16, %11 row_newbcast:11 row_mask:0xf bank_mask:0xf\n\t" \
  "v_fmac_f32_dpp %12, %16, %12 row_newbcast:12 row_mask:0xf bank_mask:0xf\n\t" \
  "v_fmac_f32_dpp %13, %16, %13 row_newbcast:13 row_mask:0xf bank_mask:0xf\n\t" \
  "v_fmac_f32_dpp %14, %16, %14 row_newbcast:14 row_mask:0xf bank_mask:0xf\n\t" \
  "v_fmac_f32_dpp %15, %16, %15 row_newbcast:15 row_mask:0xf bank_mask:0xf\n\t" \
  "v_fmac_f32_dpp %0, %17, %18 row_newbcast:0 row_mask:0xf bank_mask:0xf\n\t" \
  "v_fmac_f32_dpp %1, %17, %18 row_newbcast:1 row_mask:0xf bank_mask:0xf\n\t" \
  "v_fmac_f32_dpp %2, %17, %18 row_newbcast:2 row_mask:0xf bank_mask:0xf\n\t" \
  "v_fmac_f32_dpp %3, %17, %18 row_newbcast:3 row_mask:0xf bank_mask:0xf\n\t" \
  "v_fmac_f32_dpp %4, %17, %18 row_newbcast:4 row_mask:0xf bank_mask:0xf\n\t" \
  "v_fmac_f32_dpp %5, %17, %18 row_newbcast:5 row_mask:0xf bank_mask:0xf\n\t" \
  "v_fmac_f32_dpp %6, %17, %18 row_newbcast:6 row_mask:0xf bank_mask:0xf\n\t" \
  "v_fmac_f32_dpp %7, %17, %18 row_newbcast:7 row_mask:0xf bank_mask:0xf\n\t" \
  "v_fmac_f32_dpp %8, %17, %18 row_newbcast:8 row_mask:0xf bank_mask:0xf\n\t" \
  "v_fmac_f32_dpp %9, %17, %18 row_newbcast:9 row_mask:0xf bank_mask:0xf\n\t" \
  "v_fmac_f32_dpp %10, %17, %18 row_newbcast:10 row_mask:0xf bank_mask:0xf\n\t" \
  "v_fmac_f32_dpp %11, %17, %18 row_newbcast:11 row_mask:0xf bank_mask:0xf\n\t" \
  "v_fmac_f32_dpp %12, %17, %18 row_newbcast:12 row_mask:0xf bank_mask:0xf\n\t" \
  "v_fmac_f32_dpp %13, %17, %18 row_newbcast:13 row_mask:0xf bank_mask:0xf\n\t" \
  "v_fmac_f32_dpp %14, %17, %18 row_newbcast:14 row_mask:0xf bank_mask:0xf\n\t" \
  "v_fmac_f32_dpp %15, %17, %18 row_newbcast:15 row_mask:0xf bank_mask:0xf\n\t" \
  : "+v"(S[0]), "+v"(S[1]), "+v"(S[2]), "+v"(S[3]), "+v"(S[4]), "+v"(S[5]), "+v"(S[6]), "+v"(S[7]), "+v"(S[8]), "+v"(S[9]), "+v"(S[10]), "+v"(S[11]), "+v"(S[12]), "+v"(S[13]), "+v"(S[14]), "+v"(S[15]) \
  : "v"(ne_), "v"(kp_), "v"(vv_))
#define UPD_B(nkka_, sa_) asm("v_fmac_f32_dpp %0, %16, %17 row_newbcast:0 row_mask:0xf bank_mask:0xf\n\t" \
  "v_fmac_f32_dpp %1, %16, %17 row_newbcast:1 row_mask:0xf bank_mask:0xf\n\t" \
  "v_fmac_f32_dpp %2, %16, %17 row_newbcast:2 row_mask:0xf bank_mask:0xf\n\t" \
  "v_fmac_f32_dpp %3, %16, %17 row_newbcast:3 row_mask:0xf bank_mask:0xf\n\t" \
  "v_fmac_f32_dpp %4, %16, %17 row_newbcast:4 row_mask:0xf bank_mask:0xf\n\t" \
  "v_fmac_f32_dpp %5, %16, %17 row_newbcast:5 row_mask:0xf bank_mask:0xf\n\t" \
  "v_fmac_f32_dpp %6, %16, %17 row_newbcast:6 row_mask:0xf bank_mask:0xf\n\t" \
  "v_fmac_f32_dpp %7, %16, %17 row_newbcast:7 row_mask:0xf bank_mask:0xf\n\t" \
  "v_fmac_f32_dpp %8, %16, %17 row_newbcast:8 row_mask:0xf bank_mask:0xf\n\t" \
  "v_fmac_f32_dpp %9, %16, %17 row_newbcast:9 row_mask:0xf bank_mask:0xf\n\t" \
  "v_fmac_f32_dpp %10, %16, %17 row_newbcast:10 row_mask:0xf bank_mask:0xf\n\t" \
  "v_fmac_f32_dpp %11, %16, %17 row_newbcast:11 row_mask:0xf bank_mask:0xf\n\t" \
  "v_fmac_f32_dpp %12, %16, %17 row_newbcast:12 row_mask:0xf bank_mask:0xf\n\t" \
  "v_fmac_f32_dpp %13, %16, %17 row_newbcast:13 row_mask:0xf bank_mask:0xf\n\t" \
  "v_fmac_f32_dpp %14, %16, %17 row_newbcast:14 row_mask:0xf bank_mask:0xf\n\t" \
  "v_fmac_f32_dpp %15, %16, %17 row_newbcast:15 row_mask:0xf bank_mask:0xf\n\t" \
  : "+v"(S[0]), "+v"(S[1]), "+v"(S[2]), "+v"(S[3]), "+v"(S[4]), "+v"(S[5]), "+v"(S[6]), "+v"(S[7]), "+v"(S[8]), "+v"(S[9]), "+v"(S[10]), "+v"(S[11]), "+v"(S[12]), "+v"(S[13]), "+v"(S[14]), "+v"(S[15]) \
  : "v"(nkka_), "v"(sa_))
#define REP16(M) M(0) M(1) M(2) M(3) M(4) M(5) M(6) M(7) M(8) M(9) M(10) M(11) M(12) M(13) M(14) M(15)
__device__ __forceinline__ float rowsum4(float x) {
  float a = x, b = x;
  asm volatile("s_nop 1\n\tv_permlane32_swap_b32 %0, %1" : "+v"(a), "+v"(b));
  float s = a + b;
  float c = s, d = s;
  asm volatile("s_nop 1\n\tv_permlane16_swap_b32 %0, %1" : "+v"(c), "+v"(d));
  return c + d;
}
__device__ __forceinline__ int seq_row(int p, int b, int dir) {
  if (p < 256) return b * 256 + (dir ? 255 - p : p);
  int q = p - 256;
  return TC + b * 4096 + (dir ? 4095 - q : q);
}
__device__ __forceinline__ void rwkv_scan(const Pm& P, int unit, char* smem) {
  const int tid = ftid(), wid = tid >> 6, lane = tid & 63;
  const int b = unit >> 5, h = (unit >> 1) & 15, dir = unit & 1;
  const bfr* S7b = WSP(bfr, OFF_S7);
  bfr* O = dir ? WSP(bfr, OFF_OB) : WSP(bfr, OFF_OF);
  constexpr int CHB = 64 * 6 * 64 * 2;
  const int colv = h * 64 + (wid & 3) * 16 + (lane & 15);
  float S[16];
#pragma unroll
  for (int j = 0; j < 16; j++) S[j] = 0.f;
  const int lt = tid - 256;
  auto load_chunk = [&](int c, char* buf) {
#pragma unroll
    for (int i = 0; i < 12; i++) {
      const int idx = lt + 256 * i;
      const int step = idx / 48, rem = idx - step * 48;
      const int arr = rem >> 3, part = rem & 7;
      const int am = (arr == 0) ? 0 : (arr == 1) ? 1 : (arr == 2) ? 3 : (arr == 3) ? 4 : (arr == 4) ? (5 + dir) : 2;
      const bfr* src = S7b + (size_t)am * ((size_t)T * 1024) + (size_t)seq_row(c * 64 + step, b, dir) * 1024 + h * 64 + part * 8;
      __builtin_amdgcn_global_load_lds((const unsigned*)src, (unsigned*)(buf + idx * 16), 16, 0, 0);
    }
  };
  __syncthreads();
  if (wid >= 4) {
    load_chunk(0, smem);
    asm volatile("s_waitcnt vmcnt(0)" ::: "memory");
  }
  __syncthreads();
  for (int c = 0; c < 68; c++) {
    if (wid >= 4) {
      if (c + 1 < 68) load_chunk(c + 1, smem + ((c + 1) & 1) * CHB);
      asm volatile("s_waitcnt vmcnt(0)" ::: "memory");
    } else {
      const bfr* buf = (const bfr*)(smem + (c & 1) * CHB);
      const int q_ = lane >> 4;
      const int rbase_c = seq_row(c * 64, b, dir);
      const int sgn = dir ? -1 : 1;
      bfr* Oq = O + (size_t)(rbase_c + sgn * q_) * 1024 + colv;
      auto ld = [&](int s, bfr (&x)[6]) {
        const bfr* sp = buf + s * 384;
        x[0] = sp[lane]; x[1] = sp[64 + lane]; x[2] = sp[128 + lane]; x[3] = sp[192 + lane]; x[4] = sp[256 + lane];
        x[5] = sp[320 + wid * 16 + (lane & 15)];
      };
      auto group = [&](bfr (&X)[4][6], int s) {
        float op[4];
#pragma unroll
        for (int u = 0; u < 4; u++) {
          float r = b2f(X[u][0]), kp = b2f(X[u][1]), kk = b2f(X[u][2]), nkka = b2f(X[u][3]), ne = b2f(X[u][4]), vv = b2f(X[u][5]);
          asm volatile("s_nop 1" : "+v"(kk), "+v"(nkka), "+v"(ne), "+v"(kp), "+v"(r));
          float sa0, sa1, sa2, sa3;
          DOT16(sa0, sa1, sa2, sa3, kk);
          UPD_A(ne, kp, vv);
          float sa = rowsum4((sa0 + sa1) + (sa2 + sa3));
          UPD_B(nkka, sa);
          float o0, o1, o2, o3;
          DOT16(o0, o1, o2, o3, r);
          op[u] = (o0 + o1) + (o2 + o3);
        }
        float a_ = op[0], c_ = op[2], b_ = op[1], d_ = op[3];
        asm volatile("s_nop 1\n\tv_permlane32_swap_b32 %0, %1" : "+v"(a_), "+v"(c_));
        asm volatile("s_nop 1\n\tv_permlane32_swap_b32 %0, %1" : "+v"(b_), "+v"(d_));
        float s02 = a_ + c_, s13 = b_ + d_;
        asm volatile("s_nop 1\n\tv_permlane16_swap_b32 %0, %1" : "+v"(s02), "+v"(s13));
        const float tot = s02 + s13;
        Oq[(ptrdiff_t)sgn * s * 1024] = f2b(tot);
      };
      bfr XA[4][6], XB[4][6];
#pragma unroll
      for (int u = 0; u < 4; u++) ld(u, XA[u]);
      for (int s0 = 0; s0 < 64; s0 += 8) {
#pragma unroll
        for (int u = 0; u < 4; u++) ld(s0 + 4 + u, XB[u]);
        group(XA, s0);
        if (s0 + 8 < 64) {
#pragma unroll
          for (int u = 0; u < 4; u++) ld(s0 + 8 + u, XA[u]);
        }
        group(XB, s0 + 4);
      }
    }
    __syncthreads();
  }
}

__device__ __forceinline__ void rwkv_scan_simple(const Pm& P, int unit) {
  const int tid = ftid();
  const int b = unit >> 5, h = (unit >> 1) & 15, dir = unit & 1;
  const bfr* R = WSP(bfr, OFF_R); const bfr* KP = WSP(bfr, OFF_KP); const bfr* V = WSP(bfr, OFF_V);
  const bfr* KKN = WSP(bfr, OFF_KKN); const bfr* AA = WSP(bfr, OFF_AA);
  const bfr* NE = dir ? WSP(bfr, OFF_NEB) : WSP(bfr, OFF_NEF);
  bfr* O = dir ? WSP(bfr, OFF_OB) : WSP(bfr, OFF_OF);
  const int v = tid >> 3, kq = tid & 7;
  float S[8];
#pragma unroll
  for (int j = 0; j < 8; j++) S[j] = 0.f;
  for (int p = 0; p < 4352; p++) {
    const size_t rw = (size_t)seq_row(p, b, dir) * 1024 + h * 64;
    const size_t ro = rw + kq * 8;
    u16x8 r8 = *(const u16x8*)(R + ro), kp8 = *(const u16x8*)(KP + ro), kk8 = *(const u16x8*)(KKN + ro);
    u16x8 aa8 = *(const u16x8*)(AA + ro), ne8 = *(const u16x8*)(NE + ro);
    const float vv = b2f(V[rw + v]);
    float sa = 0.f;
#pragma unroll
    for (int j = 0; j < 8; j++) sa += S[j] * b2f(kk8[j]);
    sa += __shfl_xor(sa, 1); sa += __shfl_xor(sa, 2); sa += __shfl_xor(sa, 4);
    float o = 0.f;
#pragma unroll
    for (int j = 0; j < 8; j++) {
      S[j] = S[j] + b2f(ne8[j]) * S[j] + sa * b2f(aa8[j]) + vv * b2f(kp8[j]);
      o += S[j] * b2f(r8[j]);
    }
    o += __shfl_xor(o, 1); o += __shfl_xor(o, 2); o += __shfl_xor(o, 4);
    if (kq == 0) O[rw + v] = f2b(o);
  }
}

constexpr int QS = 136;
constexpr int TS = 72;
__device__ __forceinline__ void gla_prep(const Pm& P, int l) {
  const bfr* PG = WSP(bfr, OFF_PGLA);
  unsigned short* CUM = WSP(unsigned short, OFF_CUM);
  const int nitems = 272 * 1024;
  for (int it = blockIdx.x * NTHR + ftid(); it < nitems; it += gridDim.x * NTHR) {
    const int c = it >> 10, col = it & 1023, dir = col >> 9, dd = col & 511;
    float a2c[16];
#pragma unroll
    for (int r = 0; r < 16; r++) a2c[r] = P.in[I_GA2][(((size_t)l * 2 + dir) * 16 + r) * 512 + dd];
    const float ab = P.in[I_GAB][((size_t)l * 2 + dir) * 512 + dd];
    float run = 0.f;
    for (int i = 0; i < 64; i++) {
      const int row = dir ? (64 * c + 63 - i) : (64 * c + i);
      const bfr* adp = PG + (size_t)row * NGLA + 3072 + dir * 16;
      u16x8 a0 = *(const u16x8*)adp, a1 = *(const u16x8*)(adp + 8);
      float x = ab;
#pragma unroll
      for (int r = 0; r < 8; r++) { x += b2f(a0[r]) * a2c[r]; x += b2f(a1[r]) * a2c[8 + r]; }
      const float lg = (fminf(x, 0.f) - __logf(1.0f + __expf(-fabsf(x)))) * (1.0f / 16.0f);
      run += lg;
      _Float16 hv = (_Float16)run;
      CUM[(size_t)row * 1024 + col] = __builtin_bit_cast(unsigned short, hv);
    }
  }
}
__device__ __forceinline__ float h2f(unsigned short u) { return (float)__builtin_bit_cast(_Float16, u); }

template <int NS>
__device__ __forceinline__ void chunk_scan(const Pm& P, int l, int unit, char* smem) {
  const int tid = ftid(), w = tid >> 6, lane = tid & 63, fr = lane & 15, fq = lane >> 4;
  const int b = unit >> 4, h = (unit >> 2) & 3, slice = unit & 3;
  constexpr int DK = 128 * NS;
  const bfr* Pb = (NS == 1) ? WSP(bfr, OFF_PGLA) : WSP(bfr, OFF_PRET);
  const unsigned short* CUM = WSP(unsigned short, OFF_CUM);
  constexpr int ldp = (NS == 1) ? NGLA : NRET;
  const int qoff = h * DK, koff = ((NS == 1) ? 512 : 1024) + h * DK;
  const int voff = ((NS == 1) ? 1024 : 2048) + h * 256 + slice * 64;
  bfr* O = (NS == 1) ? WSP(bfr, OFF_OGLA) : WSP(bfr, OFF_ORET);
  const int ocol = h * 256 + slice * 64;
  const float qscale = (NS == 1) ? 0.08838834764831845f : 1.0f;

  bfr* Qi = (bfr*)smem;
  bfr* Ki = (bfr*)(smem + 17408);
  bfr* KoT = (bfr*)(smem + 34816);
  bfr* VT = (bfr*)(smem + 53248);
  bfr* Pm_ = (bfr*)(smem + 62464);
  bfr* ST = (bfr*)(smem + 71680);
  float* lastv = (float*)(smem + 71680 + NS * 17408);

  const int d = tid & 127, tq = tid >> 7;
  const int t2 = tid >> 4, db = tid & 15;
  const int vc = tid & 63, tg = tid >> 6;
  const int mt = w >> 1, nb = (w & 1) * 2;

  for (int dir = 0; dir < 2; dir++) {
    const int sgn = dir ? -1 : 1;
    auto rbase_of = [&](int n) {
      if (n < 4) return dir ? (b * 256 + 255 - 64 * n) : (b * 256 + 64 * n);
      return dir ? (TC + b * 4096 + 4095 - 64 * (n - 4)) : (TC + b * 4096 + 64 * (n - 4));
    };
    f32x4 acc_st[NS][4];
#pragma unroll
    for (int s = 0; s < NS; s++)
#pragma unroll
      for (int v = 0; v < 4; v++) acc_st[s][v] = f32x4{0.f, 0.f, 0.f, 0.f};
    __syncthreads();
    for (int e = tid; e < NS * 64 * QS; e += NTHR) ST[e] = 0;
    float lgam = 0.f;
    if (NS == 2) lgam = -__expf(P.in[I_RDEC][((size_t)l * 2 + dir) * 4 + h]);
    const u16x8 z8 = {0, 0, 0, 0, 0, 0, 0, 0};
    u16x8 pq8[2], pk8[2], pc8[2];
    bfr pv[8], po_next[8], po_cur[8];
    unsigned short plast = 0;
    pq8[0] = pq8[1] = pk8[0] = pk8[1] = pc8[0] = pc8[1] = z8;
#pragma unroll
    for (int i = 0; i < 8; i++) { pv[i] = 0; po_next[i] = 0; po_cur[i] = 0; }
    auto issue = [&](int n, int s) {
      const int rb = rbase_of(n);
      if (s == 0) {
#pragma unroll
        for (int i = 0; i < 8; i++) pv[i] = Pb[(size_t)(rb + sgn * (8 * tg + i)) * ldp + voff + vc];
        if (NS == 1 && tid < 128) plast = CUM[(size_t)(rb + sgn * 63) * 1024 + dir * 512 + h * 128 + tid];
        if (dir) {
#pragma unroll
          for (int j = 0; j < 2; j++)
#pragma unroll
            for (int jj = 0; jj < 4; jj++)
              po_next[j * 4 + jj] = O[(size_t)(rb + sgn * (16 * mt + fq * 4 + jj)) * 1024 + ocol + 16 * (nb + j) + fr];
        }
      }
#pragma unroll
      for (int i = 0; i < 2; i++) {
        const int row = rb + sgn * (t2 + 32 * i);
        const size_t ro = (size_t)row * ldp;
        pq8[i] = *(const u16x8*)(Pb + ro + qoff + s * 128 + db * 8);
        pk8[i] = *(const u16x8*)(Pb + ro + koff + s * 128 + db * 8);
        if (NS == 1) pc8[i] = *(const u16x8*)(CUM + (size_t)row * 1024 + dir * 512 + h * 128 + db * 8);
      }
    };
    issue(0, 0);
    for (int n = 0; n < 68; n++) {
      const int rbase = rbase_of(n);
      __syncthreads();
      {
        u16x8 vv;
#pragma unroll
        for (int i = 0; i < 8; i++) vv[i] = pv[i];
        *(u16x8*)(VT + vc * TS + 8 * tg) = vv;
      }
#pragma unroll
      for (int i = 0; i < 8; i++) po_cur[i] = po_next[i];
      f32x4 acc_s[2], acc_o[2];
      acc_s[0] = acc_s[1] = acc_o[0] = acc_o[1] = f32x4{0.f, 0.f, 0.f, 0.f};
#pragma unroll
      for (int s = 0; s < NS; s++) {
        if (NS == 1) {
          if (tid < 128) lastv[tid] = h2f(plast);
        } else {
          if (tid < 128) lastv[s * 128 + tid] = 64.0f * lgam;
        }
#pragma unroll
        for (int i = 0; i < 2; i++) {
          const int t = t2 + 32 * i;
          u16x8 qo, ko;
          if (NS == 1) {
#pragma unroll
            for (int e = 0; e < 8; e++) {
              const float c = h2f(pc8[i][e]);
              qo[e] = f2b(b2f(pq8[i][e]) * qscale * __expf(c));
              ko[e] = f2b(b2f(pk8[i][e]) * __expf(-c));
            }
          } else {
            const float c = (float)(t + 1) * lgam;
            const float eq = __expf(c), ek = __expf(-c);
#pragma unroll
            for (int e = 0; e < 8; e++) {
              qo[e] = f2b(b2f(pq8[i][e]) * eq);
              ko[e] = f2b(b2f(pk8[i][e]) * ek);
            }
          }
          *(u16x8*)(Qi + t * QS + db * 8) = qo;
          *(u16x8*)(Ki + t * QS + db * 8) = ko;
        }
        if (s + 1 < NS) issue(n, s + 1);
        else if (n + 1 < 68) issue(n + 1, 0);
        __syncthreads();
        {
          u16x8 k0, k1;
#pragma unroll
          for (int i = 0; i < 8; i++) { k0[i] = Ki[(16 * tq + i) * QS + d]; k1[i] = Ki[(16 * tq + 8 + i) * QS + d]; }
          *(u16x8*)(KoT + d * TS + 16 * tq) = k0;
          *(u16x8*)(KoT + d * TS + 16 * tq + 8) = k1;
        }
#pragma unroll
        for (int kk = 0; kk < 4; kk++) {
          bf16x8 a = *(const bf16x8*)(Qi + (16 * mt + fr) * QS + kk * 32 + fq * 8);
#pragma unroll
          for (int j = 0; j < 2; j++) {
            const int nt = nb + j;
            if (nt <= mt) {
              bf16x8 bb = *(const bf16x8*)(Ki + (16 * nt + fr) * QS + kk * 32 + fq * 8);
              acc_s[j] = __builtin_amdgcn_mfma_f32_16x16x32_bf16(a, bb, acc_s[j], 0, 0, 0);
            }
            bf16x8 sb = *(const bf16x8*)(ST + s * 64 * QS + (16 * nt + fr) * QS + kk * 32 + fq * 8);
            acc_o[j] = __builtin_amdgcn_mfma_f32_16x16x32_bf16(a, sb, acc_o[j], 0, 0, 0);
          }
        }
        __syncthreads();
        {
#pragma unroll
          for (int kk = 0; kk < 2; kk++) {
            bf16x8 bb = *(const bf16x8*)(KoT + (16 * w + fr) * TS + kk * 32 + fq * 8);
#pragma unroll
            for (int vt = 0; vt < 4; vt++) {
              bf16x8 a = *(const bf16x8*)(VT + (16 * vt + fr) * TS + kk * 32 + fq * 8);
              acc_st[s][vt] = __builtin_amdgcn_mfma_f32_16x16x32_bf16(a, bb, acc_st[s][vt], 0, 0, 0);
            }
          }
          const float dec = __expf(lastv[s * 128 + 16 * w + fr]);
#pragma unroll
          for (int vt = 0; vt < 4; vt++) acc_st[s][vt] *= dec;
        }
        __syncthreads();
#pragma unroll
        for (int vt = 0; vt < 4; vt++)
#pragma unroll
          for (int j = 0; j < 4; j++) ST[s * 64 * QS + (16 * vt + fq * 4 + j) * QS + 16 * w + fr] = f2b(acc_st[s][vt][j]);
      }
#pragma unroll
      for (int j = 0; j < 2; j++) {
        const int nt = nb + j;
#pragma unroll
        for (int jj = 0; jj < 4; jj++) {
          const int t = 16 * mt + fq * 4 + jj, sc = 16 * nt + fr;
          float val = (sc <= t) ? acc_s[j][jj] : 0.f;
          Pm_[t * TS + sc] = f2b(val);
        }
      }
      __syncthreads();
#pragma unroll
      for (int kk = 0; kk < 2; kk++) {
        bf16x8 a = *(const bf16x8*)(Pm_ + (16 * mt + fr) * TS + kk * 32 + fq * 8);
#pragma unroll
        for (int j = 0; j < 2; j++) {
          bf16x8 bb = *(const bf16x8*)(VT + (16 * (nb + j) + fr) * TS + kk * 32 + fq * 8);
          acc_o[j] = __builtin_amdgcn_mfma_f32_16x16x32_bf16(a, bb, acc_o[j], 0, 0, 0);
        }
      }
#pragma unroll
      for (int j = 0; j < 2; j++)
#pragma unroll
        for (int jj = 0; jj < 4; jj++) {
          const int t = 16 * mt + fq * 4 + jj;
          bfr* addr = O + (size_t)(rbase + sgn * t) * 1024 + ocol + 16 * (nb + j) + fr;
          float val = acc_o[j][jj];
          if (dir) val += b2f(po_cur[j * 4 + jj]);
          *addr = f2b(val);
        }
    }
  }
}

__device__ __forceinline__ void finish(const Pm& P, int l) {
  const int tid_ = ftid();
  const int lane = tid_ & 63, wid = tid_ >> 6;
  const int c0 = lane * 16;
  bfr* OF = WSP(bfr, OFF_OF); const bfr* OB = WSP(bfr, OFF_OB); const bfr* G = WSP(bfr, OFF_G);
  const bfr* R = WSP(bfr, OFF_R); const bfr* KP = WSP(bfr, OFF_KP); const bfr* V = WSP(bfr, OFF_V);
  bfr* OG = WSP(bfr, OFF_OGLA); bfr* OR_ = WSP(bfr, OFF_ORET);
  const bfr* PGL = WSP(bfr, OFF_PGLA); const bfr* PRT = WSP(bfr, OFF_PRET);
  const float* lng = P.in[I_LNG] + (size_t)l * 1024 + c0; const float* lnb = P.in[I_LNB] + (size_t)l * 1024 + c0;
  const float* rk = P.in[I_RK] + (size_t)l * 1024 + c0;
  const float* gng = P.in[I_GNG] + (size_t)l * 1024 + c0; const float* rng = P.in[I_RNG] + (size_t)l * 1024 + c0;
  for (int row = blockIdx.x * 8 + wid; row < T; row += gridDim.x * 8) {
    const size_t ro = (size_t)row * 1024 + c0;
    {
      float o[16], rr[16], kk[16], vv[16], gg[16];
#pragma unroll
      for (int hh = 0; hh < 2; hh++) {
        u16x8 a = *(const u16x8*)(OF + ro + hh * 8), bq = *(const u16x8*)(OB + ro + hh * 8);
        u16x8 r8 = *(const u16x8*)(R + ro + hh * 8), k8 = *(const u16x8*)(KP + ro + hh * 8), v8 = *(const u16x8*)(V + ro + hh * 8);
        u16x8 g8 = *(const u16x8*)(G + ro + hh * 8);
#pragma unroll
        for (int e = 0; e < 8; e++) {
          o[hh * 8 + e] = b2f(a[e]) + b2f(bq[e]);
          rr[hh * 8 + e] = b2f(r8[e]); kk[hh * 8 + e] = b2f(k8[e]); vv[hh * 8 + e] = b2f(v8[e]); gg[hh * 8 + e] = b2f(g8[e]);
        }
      }
      float s1 = 0.f, sb = 0.f;
#pragma unroll
      for (int i = 0; i < 16; i++) { s1 += o[i]; sb += rr[i] * kk[i] * rk[i]; }
      s1 += __shfl_xor(s1, 1); s1 += __shfl_xor(s1, 2);
      sb += __shfl_xor(sb, 1); sb += __shfl_xor(sb, 2);
      const float mean = s1 * (1.0f / 64.0f);
      float s2 = 0.f;
#pragma unroll
      for (int i = 0; i < 16; i++) { o[i] -= mean; s2 += o[i] * o[i]; }
      s2 += __shfl_xor(s2, 1); s2 += __shfl_xor(s2, 2);
      const float rs = rsqrtf(s2 * (1.0f / 64.0f) + 64e-5f);
      u16x8 w0, w1;
#pragma unroll
      for (int i = 0; i < 16; i++) {
        float y = o[i] * rs * lng[i] + lnb[i];
        bfr ov = f2b((y + sb * vv[i]) * gg[i]);
        if (ZERO_BRANCH == 1) ov = 0;
        if (i < 8) w0[i] = ov; else w1[i - 8] = ov;
      }
      *(u16x8*)(OF + ro) = w0; *(u16x8*)(OF + ro + 8) = w1;
    }
#pragma unroll
    for (int mx = 0; mx < 2; mx++) {
      bfr* Ob = mx ? OR_ : OG;
      const bfr* gsrc = mx ? (PRT + (size_t)row * NRET + 3072 + c0) : (PGL + (size_t)row * NGLA + 2048 + c0);
      const float* ng = mx ? rng : gng;
      float o[16], gt[16];
#pragma unroll
      for (int hh = 0; hh < 2; hh++) {
        u16x8 a = *(const u16x8*)(Ob + ro + hh * 8), g8 = *(const u16x8*)(gsrc + hh * 8);
#pragma unroll
        for (int e = 0; e < 8; e++) { o[hh * 8 + e] = b2f(a[e]); gt[hh * 8 + e] = b2f(g8[e]); }
      }
      if (mx) {
        float s1 = 0.f;
#pragma unroll
        for (int i = 0; i < 16; i++) s1 += o[i];
        s1 += __shfl_xor(s1, 1); s1 += __shfl_xor(s1, 2); s1 += __shfl_xor(s1, 4); s1 += __shfl_xor(s1, 8);
        const float mean = s1 * (1.0f / 256.0f);
#pragma unroll
        for (int i = 0; i < 16; i++) o[i] -= mean;
      }
      float s2 = 0.f;
#pragma unroll
      for (int i = 0; i < 16; i++) s2 += o[i] * o[i];
      s2 += __shfl_xor(s2, 1); s2 += __shfl_xor(s2, 2); s2 += __shfl_xor(s2, 4); s2 += __shfl_xor(s2, 8);
      const float rs = rsqrtf(s2 * (1.0f / 256.0f) + 1e-5f);
      u16x8 w0, w1;
#pragma unroll
      for (int i = 0; i < 16; i++) {
        bfr ov = f2b(o[i] * rs * ng[i] * siluf_(gt[i]));
        if (ZERO_BRANCH == 2 + mx) ov = 0;
        if (i < 8) w0[i] = ov; else w1[i - 8] = ov;
      }
      *(u16x8*)(Ob + ro) = w0; *(u16x8*)(Ob + ro + 8) = w1;
    }
  }
}


constexpr int STAGE256 = 65536;
__device__ __forceinline__ void gemm256_stage(const bfr* __restrict__ A, int lda, const bfr* __restrict__ Bt, int ldb, int row0,
                                              int col0, int k0, char* st, int tid) {
#pragma unroll
  for (int s = 0; s < 2; s++) {
#pragma unroll
    for (int i = 0; i < 2; i++) {
      int c = tid + i * NTHR;
      int r = c >> 2, kc = (((c & 3) ^ ((0x1320 >> (r & 12)) & 3))) * 8;
      __builtin_amdgcn_global_load_lds((const unsigned*)(A + (size_t)(row0 + r) * lda + k0 + s * 32 + kc),
                                       (unsigned*)(st + s * 16384 + c * 16), 16, 0, 0);
      __builtin_amdgcn_global_load_lds((const unsigned*)(Bt + (size_t)(col0 + r) * ldb + k0 + s * 32 + kc),
                                       (unsigned*)(st + 32768 + s * 16384 + c * 16), 16, 0, 0);
    }
  }
}
__device__ __forceinline__ void gemm256_compute(const char* st, f32x4 (&acc)[8][4], int wr, int wc, int fr, int fq) {
  const int fqs = fq ^ ((0x1320 >> (fr & 12)) & 3);
#pragma unroll
  for (int s = 0; s < 2; s++) {
    bf16x8 b[4];
#pragma unroll
    for (int n = 0; n < 4; n++) b[n] = *(const bf16x8*)(st + 32768 + s * 16384 + ((wc * 64 + n * 16 + fr) * 32 + fqs * 8) * 2);
#pragma unroll
    for (int mh = 0; mh < 2; mh++) {
      bf16x8 a[4];
#pragma unroll
      for (int m = 0; m < 4; m++) a[m] = *(const bf16x8*)(st + s * 16384 + ((wr * 128 + mh * 64 + m * 16 + fr) * 32 + fqs * 8) * 2);
      __builtin_amdgcn_sched_barrier(0);
#pragma unroll
      for (int m = 0; m < 4; m++)
#pragma unroll
        for (int n = 0; n < 4; n++) acc[mh * 4 + m][n] = __builtin_amdgcn_mfma_f32_16x16x32_bf16(a[m], b[n], acc[mh * 4 + m][n], 0, 0, 0);
      __builtin_amdgcn_sched_barrier(0);
    }
  }
}
template <class Epi>
__device__ __forceinline__ void gemm_phase256(const bfr* A, int lda, const bfr* Bt, int ldb, int M, int N, int K, const Epi& epi,
                                              char* smem) {
  const int nM = M >> 8, nN = N >> 8, nk = K >> 6;
  const int tid = ftid(), wid = tid >> 6, lane = tid & 63;
  const int wr = wid >> 2, wc = wid & 3, fr = lane & 15, fq = lane >> 4;
  bool pre = false;
  for (int tile = blockIdx.x; tile < nM * nN; tile += gridDim.x) {
    int mt, nt;
    tile_map(tile, nM, nN, mt, nt);
    f32x4 acc[8][4];
#pragma unroll
    for (int m = 0; m < 8; m++)
#pragma unroll
      for (int n = 0; n < 4; n++) acc[m][n] = f32x4{0.f, 0.f, 0.f, 0.f};
    if (!pre) gemm256_stage(A, lda, Bt, ldb, mt * 256, nt * 256, 0, smem, tid);
#pragma unroll 1
    for (int kt = 0; kt < nk; kt++) {
      asm volatile("s_waitcnt vmcnt(0)" ::: "memory");
      __syncthreads();
      if (kt + 1 < nk) gemm256_stage(A, lda, Bt, ldb, mt * 256, nt * 256, (kt + 1) * 64, smem + ((kt + 1) & 1) * STAGE256, tid);
      gemm256_compute(smem + (kt & 1) * STAGE256, acc, wr, wc, fr, fq);
    }
    __syncthreads();
    pre = false;
    if (tile + (int)gridDim.x < nM * nN) {
      int mt2, nt2;
      tile_map(tile + (int)gridDim.x, nM, nN, mt2, nt2);
      gemm256_stage(A, lda, Bt, ldb, mt2 * 256, nt2 * 256, 0, smem, tid);
      pre = true;
    }
#pragma unroll
    for (int hh = 0; hh < 2; hh++) {
      f32x4 part[4][4];
#pragma unroll
      for (int m = 0; m < 4; m++)
#pragma unroll
        for (int n = 0; n < 4; n++) part[m][n] = acc[hh * 4 + m][n];
      epi(part, mt * 256 + wr * 128 + hh * 64, nt * 256 + wc * 64, fr, fq);
    }
  }
}

#define XB_TMO      128
#define XB_XCNT(j)  (256  + 64 * (j))
#define XB_XSUB(j)  (1280 + 64 * (j))
#define XB_XGEN(j)  (2304 + 64 * (j))
#define XB_TOP      3328
#define XB_TOPGEN   3392
#define XCD_BAR_WORDS 3456
#define XB_SPIN_CAP (1u << 18)
#define LAS __attribute__((address_space(3)))

__device__ __forceinline__ unsigned xb_ld(unsigned* p)              { return __hip_atomic_load(p, __ATOMIC_RELAXED, __HIP_MEMORY_SCOPE_AGENT); }
__device__ __forceinline__ unsigned xb_add(unsigned* p, unsigned v) { return __hip_atomic_fetch_add(p, v, __ATOMIC_RELAXED, __HIP_MEMORY_SCOPE_AGENT); }
__device__ __forceinline__ unsigned xb_xcc_id() { return (unsigned)__builtin_amdgcn_s_getreg((3 << 11) | 20) & 0xFu; }
#define XB_SPIN(cond, bar) do { unsigned _sp = 0; while (cond) { __builtin_amdgcn_s_sleep(1); \
    if ((++_sp & 255u) == 0u) { if (xb_ld(&(bar)[XB_TMO])) break; if (_sp > XB_SPIN_CAP) { atomicAdd(&(bar)[XB_TMO], 1u); break; } } } } while (0)

struct XcdBarrier {
    unsigned* bar; unsigned x;
    volatile LAS unsigned* st;
};

__device__ __forceinline__ XcdBarrier xcd_barrier_post(unsigned* bar, volatile LAS unsigned* st) {
    XcdBarrier b; b.bar = bar; b.x = xb_xcc_id(); b.st = st;
    if (threadIdx.x == 0) (void)xb_add(&bar[XB_XCNT(b.x)], 1u);
    return b;
}
__device__ __forceinline__ void xcd_barrier_complete(unsigned* bar, unsigned x, unsigned& nloc, unsigned& nx) {
    const unsigned G = gridDim.x * gridDim.y * gridDim.z;
    unsigned sum, cnt, mine, sp = 0u;
    for (;;) {
        sum = 0u; cnt = 0u; mine = 0u;
#pragma unroll
        for (unsigned j = 0; j < 16; ++j) { const unsigned c = xb_ld(&bar[XB_XCNT(j)]); sum += c; cnt += (c > 0u) ? 1u : 0u; mine = (j == x) ? c : mine; }
        if (sum == G) break;
        __builtin_amdgcn_s_sleep(1);
        if ((++sp & 255u) == 0u) { if (xb_ld(&bar[XB_TMO])) break; if (sp > XB_SPIN_CAP) { atomicAdd(&bar[XB_TMO], 1u); break; } }
    }
    nloc = mine > 0u ? mine : 1u; nx = cnt > 0u ? cnt : 1u;
}

__device__ __forceinline__ void xcd_barrier(const XcdBarrier& b) {
    asm volatile("s_waitcnt vmcnt(0)" ::: "memory");
    __syncthreads();
    if (threadIdx.x == 0) {
        unsigned* bar = b.bar;
        __builtin_amdgcn_s_waitcnt(0);
        unsigned nloc = b.st[0], nx = b.st[1];
        if (nloc == 0u) { xcd_barrier_complete(bar, b.x, nloc, nx); b.st[0] = nloc; b.st[1] = nx; }
        const unsigned old = xb_add(&bar[XB_XSUB(b.x)], 1u);
        const unsigned gen = old / nloc;
        if (old + 1u == (gen + 1u) * nloc) {
            __builtin_amdgcn_fence(__ATOMIC_RELEASE, "agent");
            asm volatile("s_waitcnt vmcnt(0)" ::: "memory");
            const unsigned og = xb_add(&bar[XB_TOP], 1u);
            const unsigned tg = og / nx;
            if (og + 1u == (tg + 1u) * nx) xb_add(&bar[XB_TOPGEN], 1u);
            else XB_SPIN(xb_ld(&bar[XB_TOPGEN]) == tg, bar);
            __builtin_amdgcn_fence(__ATOMIC_ACQUIRE, "agent");
            xb_add(&bar[XB_XGEN(b.x)], 1u);
            asm volatile("s_waitcnt vmcnt(0)" ::: "memory");
        } else {
            XB_SPIN(xb_ld(&bar[XB_XGEN(b.x)]) == gen, bar);
            __builtin_amdgcn_fence(__ATOMIC_ACQUIRE, "agent");
            asm volatile("s_waitcnt vmcnt(0)" ::: "memory");
        }
    }
    __syncthreads();
}


#define FRESH(Q) Pm Q = P0; asm volatile("" : "+s"(Q.ws))
__global__ void __launch_bounds__(NTHR) mega_kernel(Pm P0) {
  extern __shared__ __attribute__((aligned(16))) char smem[];
  cg::grid_group grid = cg::this_grid();
  unsigned* barw = (unsigned*)(P0.ws + OFF_BAR);
  if (blockIdx.x == 0) for (int i = threadIdx.x; i < XCD_BAR_WORDS; i += NTHR) barw[i] = 0u;
  if (threadIdx.x == 0) *(uint4*)(smem + 147456) = make_uint4(0u, 0u, 0u, 0u);
  grid.sync();
  XcdBarrier xb = xcd_barrier_post(barw, (volatile LAS unsigned*)(smem + 147456));

  for (int rep_ = 0; rep_ < ((REPEAT_MASK & 128) ? 2 : 1); rep_++) {
  { FRESH(P); phase_mod(P, smem); }
  { FRESH(P); convert_layer(P, 0, smem); }
  }
  xcd_barrier(xb);
  { FRESH(P); rowwise(P, 0, 0); }
  xcd_barrier(xb);

#pragma unroll 1
  for (int l = 0; l < DEPTH; l++) {
    for (int rep_ = 0; rep_ < ((REPEAT_MASK & 1) ? 2 : 1); rep_++) {
      { FRESH(P); gemm_phase256(WSP(bfr, OFF_A), 1024, WBF(W_RW), 1024, T, NRW + NGLA + NRET, 1024, EpiIn{P.ws, smem}, smem); }
    }
    xcd_barrier(xb);
    for (int rep_ = 0; rep_ < ((REPEAT_MASK & 64) ? 2 : 1); rep_++) { FRESH(P); rwkv_lerp(P, l); }
    { FRESH(P); ret_prep(P); }
    for (int rep_ = 0; rep_ < ((REPEAT_MASK & 64) ? 2 : 1); rep_++) { FRESH(P); gla_prep(P, l); }
    xcd_barrier(xb);
    {
      { FRESH(P); gemm_phase(WSP(bfr, OFF_SM) + 0, 320, WBF(W_L2F), 64, T, 1024, 64, EpiDecay{P.in[I_W0] + ((size_t)l * 2 + 0) * 1024, WSP(bfr, OFF_NEF), smem}, smem, 0, 0); }
      { FRESH(P); gemm_phase(WSP(bfr, OFF_SM) + 64, 320, WBF(W_L2B), 64, T, 1024, 64, EpiDecay{P.in[I_W0] + ((size_t)l * 2 + 1) * 1024, WSP(bfr, OFF_NEB), smem}, smem, 544, 0); }
      { FRESH(P); gemm_phase(WSP(bfr, OFF_SM) + 128, 320, WBF(W_LA2), 64, T, 1024, 64,
                 EpiA{P.in[I_A0] + (size_t)l * 1024, P.in[I_KK] + (size_t)l * 1024, P.in[I_KA] + (size_t)l * 1024, WSP(bfr, OFF_KP),
                      WSP(bfr, OFF_KKN), WSP(bfr, OFF_AA)}, smem, 1088, 0); }
      { FRESH(P); gemm_phase(WSP(bfr, OFF_SM) + 192, 320, WBF(W_LG2), 128, T, 1024, 128, EpiBf16{WSP(bfr, OFF_G), 1024, smem}, smem, 1632, 0); }
      if (l > 0) { FRESH(P); gemm_phase(WSP(bfr, OFF_V), 1024, WBF(W_LV1), 1024, T, 128, 1024, EpiBf16{WSP(bfr, OFF_U), 128, smem}, smem, 2176, 0); }
    }
    xcd_barrier(xb);
    if (l > 0) {
      { FRESH(P); gemm_phase(WSP(bfr, OFF_U), 128, WBF(W_LV2), 64, T, 1024, 64,
                 EpiVres{P.in[I_V0] + (size_t)(l - 1) * 1024, WSP(bfr, OFF_V), WSP(bfr, OFF_VF)}, smem, 0, 0); }
      xcd_barrier(xb);
    }
#pragma unroll 1
    for (int rep_ = 0; rep_ < ((REPEAT_MASK & 2) ? 2 : 1); rep_++)
#pragma unroll 1
    for (int u = blockIdx.x; u < 256; u += gridDim.x) {
      if (u < 128) { FRESH(P); if (SIMPLE_SCAN) rwkv_scan_simple(P, u); else rwkv_scan(P, u, smem); }
      else if (u < 192) { for (int r2_ = 0; r2_ < ((REPEAT_MASK & 16) ? 2 : 1); r2_++) { FRESH(P); chunk_scan<1>(P, l, u - 128, smem); } }
      else { for (int r2_ = 0; r2_ < ((REPEAT_MASK & 32) ? 2 : 1); r2_++) { FRESH(P); chunk_scan<2>(P, l, u - 192, smem); } }
    }
    xcd_barrier(xb);
    { FRESH(P); finish(P, l); }
    for (int rep_ = 0; rep_ < ((REPEAT_MASK & 4) ? 2 : 1); rep_++)
    { FRESH(P); gemm_phase256(WSP(bfr, OFF_A), 1024, WBF(W_GATE), 1024, T, NGATE, 1024, EpiSigmoid{WSP(bfr, OFF_PGATE), NGATE, smem}, smem); }
    xcd_barrier(xb);
    for (int rep_ = 0; rep_ < ((REPEAT_MASK & 4) ? 2 : 1); rep_++) {
    { FRESH(P); gemm_phase(WSP(bfr, OFF_OF), 1024, WBF(W_BR), 1024, T, 1024, 1024, EpiBranch{WSP(bfr, OFF_PGATE), WSP(bfr, OFF_MERGED), 0}, smem, 0, 0); }
    { FRESH(P); gemm_phase(WSP(bfr, OFF_OGLA), 1024, WBF(W_BR) + (size_t)1024 * 1024, 1024, T, 1024, 1024, EpiBranch{WSP(bfr, OFF_PGATE), WSP(bfr, OFF_MERGED), 1}, smem, 0, 0); }
    { FRESH(P); gemm_phase(WSP(bfr, OFF_ORET), 1024, WBF(W_BR) + (size_t)2 * 1024 * 1024, 1024, T, 1024, 1024, EpiBranch{WSP(bfr, OFF_PGATE), WSP(bfr, OFF_MERGED), 2}, smem, 0, 0); }
    }
    xcd_barrier(xb);
    for (int rep_ = 0; rep_ < ((REPEAT_MASK & 4) ? 2 : 1); rep_++)
    { FRESH(P); gemm_phase(WSP(bfr, OFF_MERGED), 1024, WBF(W_OUT), 1024, T, 1024, 1024, EpiF32{WSP(float, OFF_Y), 1024}, smem, 0, 0); }
    xcd_barrier(xb);
    { FRESH(P); rowwise(P, 1, l); }
    xcd_barrier(xb);
    for (int rep_ = 0; rep_ < ((REPEAT_MASK & 8) ? 2 : 1); rep_++)
    { FRESH(P); gemm_phase256(WSP(bfr, OFF_A), 1024, WBF(W_1), 1024, T, 4096, 1024, EpiRelu2{WSP(bfr, OFF_H), 4096, smem}, smem); }
    xcd_barrier(xb);
    for (int rep_ = 0; rep_ < ((REPEAT_MASK & 8) ? 2 : 1); rep_++)
    { FRESH(P); gemm_phase(WSP(bfr, OFF_H), 4096, WBF(W_2), 4096, T, 1024, 4096, EpiF32{WSP(float, OFF_Y), 1024}, smem, 0, 0); }
    xcd_barrier(xb);
    { FRESH(P); rowwise(P, 2, l); }
    for (int rep_ = 0; rep_ < ((REPEAT_MASK & 128) ? 2 : 1); rep_++) if (l + 1 < DEPTH) { FRESH(P); convert_layer(P, l + 1, smem); }
    xcd_barrier(xb);
  }
}

extern "C" void kernel_launch(void* const* d_in, const int* in_sizes, int n_in, void* d_out, int out_size, void* d_ws,
                              size_t ws_size, hipStream_t stream) {
  (void)in_sizes; (void)out_size;
  if (n_in < N_IN || ws_size < WS_NEED) {
    fprintf(stderr, "bad args: n_in %d ws %zu need %zu\n", n_in, ws_size, (size_t)WS_NEED);
    return;
  }
  static int grid_blocks = 0;
  if (!grid_blocks) {
    int dev = 0, cus = 0, per_cu = 0;
    hipGetDevice(&dev);
    hipDeviceGetAttribute(&cus, hipDeviceAttributeMultiprocessorCount, dev);
    hipFuncSetAttribute((const void*)mega_kernel, hipFuncAttributeMaxDynamicSharedMemorySize, SMEM_BYTES);
    hipOccupancyMaxActiveBlocksPerMultiprocessor(&per_cu, mega_kernel, NTHR, SMEM_BYTES);
    if (per_cu < 1) per_cu = 1;
    if (per_cu > 1) per_cu = 1;
    grid_blocks = cus * per_cu;
  }
  Pm p;
  memset(&p, 0, sizeof(p));
  for (int i = 0; i < N_IN; i++) p.in[i] = (const float*)d_in[i];
  p.out = (float*)d_out;
  p.ws = (char*)d_ws;
  void* args[] = {&p};
  hipError_t e = hipLaunchCooperativeKernel((void*)mega_kernel, dim3(grid_blocks), dim3(NTHR), args, SMEM_BYTES, stream);
  if (e != hipSuccess) fprintf(stderr, "cooperative launch failed: %s (grid %d)\n", hipGetErrorString(e), grid_blocks);
}
```

```cpp
#include <hip/hip_runtime.h>
#include <hip/hip_bf16.h>
#include <hip/hip_cooperative_groups.h>
#include <cstdio>
#include <cstdint>
#include <cstring>
namespace cg = cooperative_groups;

typedef unsigned short bfr;
using bf16x8 = __attribute__((ext_vector_type(8))) short;
using f32x4 = __attribute__((ext_vector_type(4))) float;
using u16x8 = __attribute__((ext_vector_type(8))) unsigned short;

constexpr int D = 1024, TC = 1024, TL = 16384, T = 17408, DEPTH = 4;
constexpr int NRW = 3584, NGLA = 3328, NRET = 4096, NGATE = 3072;
constexpr int D_IN = 13664;
constexpr int NTHR = 512;

enum { I_X = 0, I_C, I_CTX, I_CCTX, I_ADAW, I_ADAB, I_NPREMIX, I_NPOSTMIX, I_NPREMLP, I_NPOSTMLP, I_WIN, I_MU, I_W0,
       I_W2, I_A0, I_A2, I_G2, I_V0, I_V1, I_V2, I_KK, I_KA, I_RK, I_LNG, I_LNB, I_GA2, I_GAB, I_GNG, I_RDEC, I_RNG,
       I_WBR, I_WOUT, I_W1, I_W2M, N_IN };

constexpr size_t al256(size_t x) { return (x + 255) & ~size_t(255); }
constexpr size_t W_RW = 0;
constexpr size_t W_GLA = W_RW + (size_t)NRW * 1024;
constexpr size_t W_RET = W_GLA + (size_t)NGLA * 1024;
constexpr size_t W_GATE = W_RET + (size_t)NRET * 1024;
constexpr size_t W_BR = W_GATE + (size_t)NGATE * 1024;
constexpr size_t W_OUT = W_BR + (size_t)3 * 1024 * 1024;
constexpr size_t W_1 = W_OUT + (size_t)1024 * 1024;
constexpr size_t W_2 = W_1 + (size_t)4096 * 1024;
constexpr size_t W_L2F = W_2 + (size_t)4096 * 1024;
constexpr size_t W_L2B = W_L2F + 1024 * 64;
constexpr size_t W_LA2 = W_L2B + 1024 * 64;
constexpr size_t W_LG2 = W_LA2 + 1024 * 64;
constexpr size_t W_LV1 = W_LG2 + 1024 * 128;
constexpr size_t W_LV2 = W_LV1 + 128 * 1024;
constexpr size_t W_END = W_LV2 + 1024 * 64;

constexpr size_t SZ = (size_t)T * 1024 * 2;
constexpr size_t OFF_W = 0;
constexpr size_t OFF_XC = al256(W_END * 2);
constexpr size_t OFF_A = OFF_XC + (size_t)1024 * 1024 * 4;
constexpr size_t OFF_VF = OFF_A + SZ;
constexpr size_t OFF_MOD = OFF_VF + SZ;
constexpr size_t OFF_PRW = al256(OFF_MOD + (size_t)4 * 5 * 6144 * 4);
constexpr size_t OFF_PGLA = OFF_PRW + (size_t)T * NRW * 2;
constexpr size_t OFF_PRET = OFF_PGLA + (size_t)T * NGLA * 2;
constexpr size_t OFF_S7 = OFF_PRET + (size_t)T * NRET * 2;
constexpr size_t OFF_SM = OFF_S7 + 7 * SZ;
constexpr size_t OFF_U = OFF_SM + (size_t)T * 320 * 2;
constexpr size_t OFF_OGLA = OFF_U + (size_t)T * 128 * 2;
constexpr size_t OFF_ORET = OFF_OGLA + SZ;
constexpr size_t OFF_CUM = OFF_ORET + SZ;
constexpr size_t OFF_BAR = OFF_CUM + SZ;
constexpr size_t WS_NEED = OFF_BAR + 16384;
constexpr size_t OFF_OF = OFF_PRW, OFF_OB = OFF_PRW + SZ, OFF_G = OFF_PRW + 2 * SZ;
constexpr size_t OFF_MERGED = OFF_PGLA;
constexpr size_t OFF_Y = OFF_PRET;
constexpr size_t OFF_R = OFF_S7, OFF_KP = OFF_S7 + SZ, OFF_V = OFF_S7 + 2 * SZ, OFF_KKN = OFF_S7 + 3 * SZ,
                 OFF_AA = OFF_S7 + 4 * SZ, OFF_NEF = OFF_S7 + 5 * SZ, OFF_NEB = OFF_S7 + 6 * SZ;
constexpr size_t OFF_PGATE = OFF_S7 + 3 * SZ;
constexpr size_t OFF_H = OFF_S7;

constexpr int SMEM_BYTES = 147456 + 64;
#define SIMPLE_SCAN 0
#define REPEAT_MASK 0
#define ZERO_BRANCH 0


struct Pm {
  const float* in[N_IN];
  float* out;
  char* ws;
};

__device__ __forceinline__ bfr f2b(float f) {
  __bf16 b = (__bf16)f;
  return __builtin_bit_cast(unsigned short, b);
}
__device__ __forceinline__ float b2f(bfr b) { return __uint_as_float(((unsigned)b) << 16); }
__device__ __forceinline__ float sigmoidf_(float x) { return __builtin_amdgcn_rcpf(1.0f + __expf(-x)); }
__device__ __forceinline__ float siluf_(float x) { return x * sigmoidf_(x); }
__device__ __forceinline__ float wave_sum(float x) {
#pragma unroll
  for (int o = 32; o >= 1; o >>= 1) x += __shfl_xor(x, o);
  return x;
}
__device__ __forceinline__ int ftid() {
  int t = threadIdx.x;
  asm volatile("" : "+v"(t));
  return t;
}
#define WSP(T_, off) ((T_*)(P.ws + (off)))
#define WBF(off) ((bfr*)(P.ws + OFF_W) + (off))

__device__ __forceinline__ void conv_T(const float* __restrict__ src, int ld, int Ksrc, int Kdst, int nvalid, int npad, bfr* __restrict__ dst,
                       char* smem) {
  float* tile = (float*)smem;
  const int tid = ftid();
  const int nk = Kdst / 64, nn = npad / 64;
  for (int t = blockIdx.x; t < nk * nn; t += gridDim.x) {
    const int kt = t % nk, nt = t / nk;
    const int k0 = kt * 64, n0 = nt * 64;
#pragma unroll
    for (int i = 0; i < 2; i++) {
      const int e = tid + i * NTHR;
      const int kk = e >> 4, nq = (e & 15) * 4;
      float4 v = make_float4(0.f, 0.f, 0.f, 0.f);
      if (k0 + kk < Ksrc && n0 + nq < nvalid) v = *(const float4*)(src + (size_t)(k0 + kk) * ld + n0 + nq);
      float* tp = tile + kk * 65 + nq;
      tp[0] = v.x; tp[1] = v.y; tp[2] = v.z; tp[3] = v.w;
    }
    __syncthreads();
    {
      const int n = tid >> 3, kc = (tid & 7) * 8;
      u16x8 o;
#pragma unroll
      for (int i = 0; i < 8; i++) o[i] = f2b(tile[(kc + i) * 65 + n]);
      *(u16x8*)(dst + (size_t)(n0 + n) * Kdst + k0 + kc) = o;
    }
    __syncthreads();
  }
}

__device__ __forceinline__ void convert_layer(const Pm& P, int l, char* smem) {
  const float* win = P.in[I_WIN] + (size_t)l * 1024 * D_IN;
  conv_T(win + 0, D_IN, 1024, 1024, 3392, NRW, WBF(W_RW), smem);
  conv_T(win + 3392, D_IN, 1024, 1024, 3104, NGLA, WBF(W_GLA), smem);
  conv_T(win + 6496, D_IN, 1024, 1024, 4096, NRET, WBF(W_RET), smem);
  conv_T(win + 10592, D_IN, 1024, 1024, 3072, NGATE, WBF(W_GATE), smem);
  for (int i = 0; i < 3; i++)
    conv_T(P.in[I_WBR] + ((size_t)l * 3 + i) * 1024 * 1024, 1024, 1024, 1024, 1024, 1024, WBF(W_BR) + (size_t)i * 1024 * 1024,
           smem);
  conv_T(P.in[I_WOUT] + (size_t)l * 1024 * 1024, 1024, 1024, 1024, 1024, 1024, WBF(W_OUT), smem);
  conv_T(P.in[I_W1] + (size_t)l * 1024 * 4096, 4096, 1024, 1024, 4096, 4096, WBF(W_1), smem);
  conv_T(P.in[I_W2M] + (size_t)l * 4096 * 1024, 1024, 4096, 4096, 1024, 1024, WBF(W_2), smem);
  conv_T(P.in[I_W2] + ((size_t)l * 2 + 0) * 64 * 1024, 1024, 64, 64, 1024, 1024, WBF(W_L2F), smem);
  conv_T(P.in[I_W2] + ((size_t)l * 2 + 1) * 64 * 1024, 1024, 64, 64, 1024, 1024, WBF(W_L2B), smem);
  conv_T(P.in[I_A2] + (size_t)l * 64 * 1024, 1024, 64, 64, 1024, 1024, WBF(W_LA2), smem);
  conv_T(P.in[I_G2] + (size_t)l * 128 * 1024, 1024, 128, 128, 1024, 1024, WBF(W_LG2), smem);
  if (l > 0) {
    conv_T(P.in[I_V1] + (size_t)(l - 1) * 1024 * 32, 32, 1024, 1024, 32, 128, WBF(W_LV1), smem);
    conv_T(P.in[I_V2] + (size_t)(l - 1) * 32 * 1024, 1024, 32, 64, 1024, 1024, WBF(W_LV2), smem);
  }
}

__device__ __forceinline__ void phase_mod(const Pm& P, char* smem) {
  float* sc = (float*)smem;
  float* red = (float*)smem + 5 * 1024;
  const int tid = ftid();
  for (int e = tid; e < 5 * 1024; e += NTHR) {
    int r = e >> 10, k = e & 1023;
    float v = (r < 4) ? P.in[I_C][r * 1024 + k] : P.in[I_CCTX][k];
    sc[e] = siluf_(v);
  }
  __syncthreads();
  float* MODV = WSP(float, OFF_MOD);
  for (int item = blockIdx.x; item < 4 * 48; item += gridDim.x) {
    const int l = item / 48, cb = item % 48;
    const int col = cb * 128 + (tid & 127), kq = tid >> 7;
    const float* w = P.in[I_ADAW] + (size_t)l * 1024 * 6144 + col;
    float acc[5] = {0, 0, 0, 0, 0};
#pragma unroll 16
    for (int k = kq * 256; k < kq * 256 + 256; k++) {
      float wv = w[(size_t)k * 6144];
#pragma unroll
      for (int r = 0; r < 5; r++) acc[r] += sc[r * 1024 + k] * wv;
    }
#pragma unroll
    for (int r = 0; r < 5; r++) red[(kq * 5 + r) * 128 + (tid & 127)] = acc[r];
    __syncthreads();
    if (kq == 0) {
      float bias = P.in[I_ADAB][(size_t)l * 6144 + col];
#pragma unroll
      for (int r = 0; r < 5; r++) {
        float s = red[(0 * 5 + r) * 128 + tid] + red[(1 * 5 + r) * 128 + tid] + red[(2 * 5 + r) * 128 + tid] +
                  red[(3 * 5 + r) * 128 + tid];
        MODV[((size_t)l * 5 + r) * 6144 + col] = s + bias;
      }
    }
    __syncthreads();
  }
}

__device__ __forceinline__ void rowwise(const Pm& P, int mode, int l) {
  const int tid_ = ftid();
  const int lane = tid_ & 63, wid = tid_ >> 6;
  const float* MODV = WSP(float, OFF_MOD);
  const float* Y = WSP(float, OFF_Y);
  bfr* A = WSP(bfr, OFF_A);
  for (int row = blockIdx.x * 8 + wid; row < T; row += gridDim.x * 8) {
    float* xr = (row < TC) ? (WSP(float, OFF_XC) + (size_t)row * 1024) : (P.out + (size_t)(row - TC) * 1024);
    const int mrow = (row < TC) ? 4 : ((row - TC) >> 12);
    const float* md = MODV + ((size_t)l * 5 + mrow) * 6144;
    const int c0 = lane * 16;
    float x[16];
    const float* xsrc = xr;
    if (mode == 0) xsrc = (row < TC) ? (P.in[I_CTX] + (size_t)row * 1024) : (P.in[I_X] + (size_t)(row - TC) * 1024);
#pragma unroll
    for (int i = 0; i < 4; i++) {
      float4 v = *(const float4*)(xsrc + c0 + i * 4);
      x[i * 4 + 0] = v.x; x[i * 4 + 1] = v.y; x[i * 4 + 2] = v.z; x[i * 4 + 3] = v.w;
    }
    if (mode != 0) {
      float y[16];
      float ss = 0.f;
#pragma unroll
      for (int i = 0; i < 4; i++) {
        float4 v = *(const float4*)(Y + (size_t)row * 1024 + c0 + i * 4);
        y[i * 4 + 0] = v.x; y[i * 4 + 1] = v.y; y[i * 4 + 2] = v.z; y[i * 4 + 3] = v.w;
      }
#pragma unroll
      for (int i = 0; i < 16; i++) ss += y[i] * y[i];
      ss = wave_sum(ss);
      const float rs = rsqrtf(ss * (1.0f / 1024.0f) + 1e-6f);
      const float* gate = md + (mode == 1 ? 2 : 5) * 1024 + c0;
      const float* gp = P.in[mode == 1 ? I_NPOSTMIX : I_NPOSTMLP] + (size_t)l * 1024 + c0;
#pragma unroll
      for (int i = 0; i < 16; i++) x[i] += gate[i] * (y[i] * rs * gp[i]);
    }
    if (mode != 2 || true) {
#pragma unroll
      for (int i = 0; i < 4; i++) *(float4*)(xr + c0 + i * 4) = make_float4(x[i * 4], x[i * 4 + 1], x[i * 4 + 2], x[i * 4 + 3]);
    }
    if (mode == 2 && l + 1 >= DEPTH) continue;
    float ss2 = 0.f;
#pragma unroll
    for (int i = 0; i < 16; i++) ss2 += x[i] * x[i];
    ss2 = wave_sum(ss2);
    const float rs2 = rsqrtf(ss2 * (1.0f / 1024.0f) + 1e-6f);
    const float *gpre, *shift, *scale;
    if (mode == 0) {
      gpre = P.in[I_NPREMIX] + c0; shift = md + c0; scale = md + 1024 + c0;
    } else if (mode == 1) {
      gpre = P.in[I_NPREMLP] + (size_t)l * 1024 + c0; shift = md + 3 * 1024 + c0; scale = md + 4 * 1024 + c0;
    } else {
      const float* md2 = MODV + ((size_t)(l + 1) * 5 + mrow) * 6144;
      gpre = P.in[I_NPREMIX] + (size_t)(l + 1) * 1024 + c0; shift = md2 + c0; scale = md2 + 1024 + c0;
    }
    u16x8 o0, o1;
#pragma unroll
    for (int i = 0; i < 8; i++) {
      o0[i] = f2b((x[i] * rs2 * gpre[i]) * (1.0f + scale[i]) + shift[i]);
      o1[i] = f2b((x[i + 8] * rs2 * gpre[i + 8]) * (1.0f + scale[i + 8]) + shift[i + 8]);
    }
    *(u16x8*)(A + (size_t)row * 1024 + c0) = o0;
    *(u16x8*)(A + (size_t)row * 1024 + c0 + 8) = o1;
  }
}

constexpr int STAGE_BYTES = 49152;
__device__ __forceinline__ void gemm_stage(const bfr* __restrict__ A, int lda, const bfr* __restrict__ Bt, int ldb, int row0,
                                           int col0, int k0, char* st, int tid) {
#pragma unroll
  for (int s = 0; s < 2; s++) {
#pragma unroll
    for (int i = 0; i < 2; i++) {
      int c = tid + i * NTHR;
      int r = c >> 2, kc = (((c & 3) ^ ((0x1320 >> (r & 12)) & 3))) * 8;
      __builtin_amdgcn_global_load_lds((const unsigned*)(A + (size_t)(row0 + r) * lda + k0 + s * 32 + kc),
                                       (unsigned*)(st + s * 16384 + c * 16), 16, 0, 0);
    }
    {
      int c = tid;
      int r = c >> 2, kc = (((c & 3) ^ ((0x1320 >> (r & 12)) & 3))) * 8;
      __builtin_amdgcn_global_load_lds((const unsigned*)(Bt + (size_t)(col0 + r) * ldb + k0 + s * 32 + kc),
                                       (unsigned*)(st + 32768 + s * 8192 + c * 16), 16, 0, 0);
    }
  }
}
struct Frags { bf16x8 a[2][4], b[2][4]; };
__device__ __forceinline__ void gemm_load_frags(const char* st, Frags& f, int wr, int wc, int fr, int fq) {
  const int fqs = fq ^ ((0x1320 >> (fr & 12)) & 3);
#pragma unroll
  for (int s = 0; s < 2; s++) {
#pragma unroll
    for (int m = 0; m < 4; m++) f.a[s][m] = *(const bf16x8*)(st + s * 16384 + ((wr * 64 + m * 16 + fr) * 32 + fqs * 8) * 2);
#pragma unroll
    for (int n = 0; n < 4; n++) f.b[s][n] = *(const bf16x8*)(st + 32768 + s * 8192 + ((wc * 64 + n * 16 + fr) * 32 + fqs * 8) * 2);
  }
}
__device__ __forceinline__ void gemm_mfma(const Frags& f, f32x4 (&acc)[4][4]) {
#pragma unroll
  for (int s = 0; s < 2; s++) {
#pragma unroll
    for (int m = 0; m < 4; m++)
#pragma unroll
      for (int n = 0; n < 4; n++) acc[m][n] = __builtin_amdgcn_mfma_f32_16x16x32_bf16(f.a[s][m], f.b[s][n], acc[m][n], 0, 0, 0);
  }
}
__device__ __forceinline__ void gemm_kloop(const bfr* __restrict__ A, int lda, const bfr* __restrict__ Bt, int ldb, int row0,
                                           int col0, int K, char* smem, f32x4 (&acc)[4][4], int tid, bool pre) {
  const int wid = tid >> 6, lane = tid & 63;
  const int wr = wid >> 1, wc = wid & 1, fr = lane & 15, fq = lane >> 4;
  const int nk = K >> 6;
  const bool grpY = wid >= 4;
  if (!pre) {
    gemm_stage(A, lda, Bt, ldb, row0, col0, 0, smem, tid);
    if (nk > 1) gemm_stage(A, lda, Bt, ldb, row0, col0, 64, smem + STAGE_BYTES, tid);
  }
  Frags F;
#pragma unroll
  for (int s = 0; s < 2; s++)
#pragma unroll
    for (int m = 0; m < 4; m++) { F.a[s][m] = bf16x8{0, 0, 0, 0, 0, 0, 0, 0}; F.b[s][m] = bf16x8{0, 0, 0, 0, 0, 0, 0, 0}; }
  int cur = 0, nxt = 2;
  for (int kt = 0; kt < nk; kt++) {
    if (kt + 1 < nk) asm volatile("s_waitcnt vmcnt(6)" ::: "memory");
    else asm volatile("s_waitcnt vmcnt(0)" ::: "memory");
    __syncthreads();
    if (kt + 2 < nk) gemm_stage(A, lda, Bt, ldb, row0, col0, (kt + 2) * 64, smem + nxt * STAGE_BYTES, tid);
    if (grpY) gemm_mfma(F, acc);
    __builtin_amdgcn_sched_barrier(0);
    gemm_load_frags(smem + cur * STAGE_BYTES, F, wr, wc, fr, fq);
    __builtin_amdgcn_sched_barrier(0);
    if (!grpY) gemm_mfma(F, acc);
    cur = (cur == 2) ? 0 : cur + 1;
    nxt = (nxt == 2) ? 0 : nxt + 1;
  }
  if (grpY) gemm_mfma(F, acc);
  __syncthreads();
}
__device__ __forceinline__ void tile_map(int tile, int nM, int nN, int& mt, int& nt) {
  const int WGM = 16;
  int nig = WGM * nN, gid = tile / nig, fm = gid * WGM;
  int gs = min(nM - fm, WGM);
  mt = fm + (tile % nig) % gs;
  nt = (tile % nig) / gs;
}

template <class Epi>
__device__ __forceinline__ void gemm_phase(const bfr* A, int lda, const bfr* Bt, int ldb, int M, int N, int K, const Epi& epi, char* smem,
                           int tile_off, int tile_total) {
  const int nM = M >> 8, nN = N >> 7;
  const int tid = ftid(), wid = tid >> 6, lane = tid & 63;
  const int wr = wid >> 1, wc = wid & 1, fr = lane & 15, fq = lane >> 4;
  int first = blockIdx.x;
  int g0 = tile_off;
  int start = ((first - (g0 % (int)gridDim.x)) % (int)gridDim.x + (int)gridDim.x) % (int)gridDim.x;
  bool pre = false;
  for (int tile = start; tile < nM * nN; tile += gridDim.x) {
    int mt, nt;
    tile_map(tile, nM, nN, mt, nt);
    f32x4 acc[4][4];
#pragma unroll
    for (int m = 0; m < 4; m++)
#pragma unroll
      for (int n = 0; n < 4; n++) acc[m][n] = f32x4{0.f, 0.f, 0.f, 0.f};
    gemm_kloop(A, lda, Bt, ldb, mt * 256, nt * 128, K, smem, acc, tid, pre);
    pre = false;
    if (tile + (int)gridDim.x < nM * nN) {
      int mt2, nt2;
      tile_map(tile + (int)gridDim.x, nM, nN, mt2, nt2);
      gemm_stage(A, lda, Bt, ldb, mt2 * 256, nt2 * 128, 0, smem, tid);
      if (K > 64) gemm_stage(A, lda, Bt, ldb, mt2 * 256, nt2 * 128, 64, smem + STAGE_BYTES, tid);
      pre = true;
    }
    epi(acc, mt * 256 + wr * 64, nt * 128 + wc * 64, fr, fq);
  }
  (void)tile_total;
}

template <class F>
__device__ __forceinline__ void wave_store_bf16(f32x4 (&acc)[4][4], const F& f, bfr* C, int ldc, int rb, int cb, int fr, int fq,
                                                char* sm) {
  const int tid_ = threadIdx.x;
  const int lane = tid_ & 63;
  bfr* sc = (bfr*)(sm + 2 * STAGE_BYTES + (tid_ >> 6) * 6144);
#pragma unroll
  for (int half = 0; half < 2; half++) {
#pragma unroll
    for (int mm = 0; mm < 2; mm++)
#pragma unroll
      for (int n = 0; n < 4; n++)
#pragma unroll
        for (int j = 0; j < 4; j++)
          sc[(mm * 16 + fq * 4 + j) * 72 + n * 16 + fr] = f2b(f(acc[half * 2 + mm][n][j], cb + n * 16 + fr));
    __builtin_amdgcn_fence(__ATOMIC_RELEASE, "wavefront");
    __builtin_amdgcn_wave_barrier();
    __builtin_amdgcn_fence(__ATOMIC_ACQUIRE, "wavefront");
#pragma unroll
    for (int it = 0; it < 4; it++) {
      const int id = it * 64 + lane;
      const int rl = id >> 3, ch = id & 7;
      u16x8 v = *(const u16x8*)(sc + rl * 72 + ch * 8);
      *(u16x8*)(C + (size_t)(rb + half * 32 + rl) * ldc + cb + ch * 8) = v;
    }
    __builtin_amdgcn_fence(__ATOMIC_RELEASE, "wavefront");
    __builtin_amdgcn_wave_barrier();
    __builtin_amdgcn_fence(__ATOMIC_ACQUIRE, "wavefront");
  }
}
struct EpiBf16 {
  bfr* C; int ldc; char* sm;
  __device__ __forceinline__ void operator()(f32x4 (&acc)[4][4], int rb, int cb, int fr, int fq) const {
    wave_store_bf16(acc, [](float v, int) { return v; }, C, ldc, rb, cb, fr, fq, sm);
  }
};
struct EpiIn {
  char* ws; char* sm;
  __device__ __forceinline__ void operator()(f32x4 (&acc)[4][4], int rb, int cb, int fr, int fq) const {
    const int seg = (cb >= NRW) + (cb >= NRW + NGLA);
    const size_t off = (seg == 0) ? OFF_PRW : ((seg == 1) ? OFF_PGLA : OFF_PRET);
    const int ldc = (seg == 0) ? NRW : ((seg == 1) ? NGLA : NRET);
    const int c0 = cb - ((seg == 0) ? 0 : ((seg == 1) ? NRW : NRW + NGLA));
    wave_store_bf16(acc, [](float v, int) { return v; }, (bfr*)(ws + off), ldc, rb, c0, fr, fq, sm);
  }
};
struct EpiF32 {
  float* C; int ldc;
  __device__ __forceinline__ void operator()(f32x4 (&acc)[4][4], int rb, int cb, int fr, int fq) const {
#pragma unroll
    for (int m = 0; m < 4; m++)
#pragma unroll
      for (int n = 0; n < 4; n++)
#pragma unroll
        for (int j = 0; j < 4; j++) C[(size_t)(rb + m * 16 + fq * 4 + j) * ldc + cb + n * 16 + fr] = acc[m][n][j];
  }
};
struct EpiRelu2 {
  bfr* C; int ldc; char* sm;
  __device__ __forceinline__ void operator()(f32x4 (&acc)[4][4], int rb, int cb, int fr, int fq) const {
    wave_store_bf16(acc, [](float v, int) { float r = fmaxf(v, 0.f); return r * r; }, C, ldc, rb, cb, fr, fq, sm);
  }
};
struct EpiSigmoid {
  bfr* C; int ldc; char* sm;
  __device__ __forceinline__ void operator()(f32x4 (&acc)[4][4], int rb, int cb, int fr, int fq) const {
    wave_store_bf16(acc, [](float v, int) { return sigmoidf_(v); }, C, ldc, rb, cb, fr, fq, sm);
  }
};
struct EpiDecay {
  const float* w0; bfr* C; char* sm;
  __device__ __forceinline__ void operator()(f32x4 (&acc)[4][4], int rb, int cb, int fr, int fq) const {
    const float* w0_ = w0;
    wave_store_bf16(acc, [w0_](float v, int col) {
      float x = w0_[col] + v;
      float lw = -0.6065306597126334f * sigmoidf_(x);
      return __expf(lw) - 1.0f;
    }, C, 1024, rb, cb, fr, fq, sm);
  }
};
struct EpiA {
  const float *a0, *k_k, *k_a;
  bfr *KP, *KKN, *AA;
  __device__ __forceinline__ void operator()(f32x4 (&acc)[4][4], int rb, int cb, int fr, int fq) const {
    float a0c[4], kkc[4], kac[4];
#pragma unroll
    for (int n = 0; n < 4; n++) {
      int col = cb + n * 16 + fr;
      a0c[n] = a0[col]; kkc[n] = k_k[col]; kac[n] = k_a[col];
    }
#pragma unroll
    for (int m = 0; m < 4; m++)
#pragma unroll
      for (int j = 0; j < 4; j++) {
        const size_t rowoff = (size_t)(rb + m * 16 + fq * 4 + j) * 1024;
        float k0[4], kr[4], av[4];
        float ss = 0.f;
#pragma unroll
        for (int n = 0; n < 4; n++) {
          int col = cb + n * 16 + fr;
          k0[n] = b2f(KP[rowoff + col]);
          kr[n] = k0[n] * kkc[n];
          ss += kr[n] * kr[n];
          av[n] = sigmoidf_(a0c[n] + acc[m][n][j]);
        }
        ss += __shfl_xor(ss, 1); ss += __shfl_xor(ss, 2); ss += __shfl_xor(ss, 4); ss += __shfl_xor(ss, 8);
        const float rn = rsqrtf(fmaxf(ss, 1e-12f));
#pragma unroll
        for (int n = 0; n < 4; n++) {
          int col = cb + n * 16 + fr;
          KKN[rowoff + col] = f2b(kr[n] * rn);
          AA[rowoff + col] = f2b(-(kr[n] * rn) * av[n]);
          KP[rowoff + col] = f2b(k0[n] * (1.0f + (av[n] - 1.0f) * kac[n]));
        }
      }
  }
};
struct EpiVres {
  const float* v0b; bfr* V; const bfr* VF;
  __device__ __forceinline__ void operator()(f32x4 (&acc)[4][4], int rb, int cb, int fr, int fq) const {
#pragma unroll
    for (int n = 0; n < 4; n++) {
      const int col = cb + n * 16 + fr;
      const float bc = v0b[col];
#pragma unroll
      for (int m = 0; m < 4; m++)
#pragma unroll
        for (int j = 0; j < 4; j++) {
          size_t idx = (size_t)(rb + m * 16 + fq * 4 + j) * 1024 + col;
          float v0 = b2f(V[idx]), vf = b2f(VF[idx]);
          V[idx] = f2b(v0 + (vf - v0) * sigmoidf_(bc + acc[m][n][j]));
        }
    }
  }
};

struct EpiBranch {
  const bfr* PG; bfr* MG; int i;
  __device__ __forceinline__ void operator()(f32x4 (&acc)[4][4], int rb, int cb, int fr, int fq) const {
#pragma unroll
    for (int n = 0; n < 4; n++) {
      const int col = cb + n * 16 + fr;
#pragma unroll
      for (int m = 0; m < 4; m++)
#pragma unroll
        for (int j = 0; j < 4; j++) {
          const size_t r_ = (size_t)(rb + m * 16 + fq * 4 + j);
          float v = b2f(PG[r_ * NGATE + i * 1024 + col]) * acc[m][n][j];
          if (i > 0) v += b2f(MG[r_ * 1024 + col]);
          MG[r_ * 1024 + col] = f2b(v);
        }
    }
  }
};

__device__ __forceinline__ void rwkv_lerp(const Pm& P, int l) {
  const bfr* PR = WSP(bfr, OFF_PRW);
  const float* mu = P.in[I_MU] + (size_t)l * 3392;
  bfr* R = WSP(bfr, OFF_R); bfr* KP = WSP(bfr, OFF_KP); bfr* V = WSP(bfr, OFF_V); bfr* VF = WSP(bfr, OFF_VF);
  bfr* SM = WSP(bfr, OFF_SM);
  const long nitems = (long)T * 424;
  for (long it = (long)blockIdx.x * NTHR + ftid(); it < nitems; it += (long)gridDim.x * NTHR) {
    const int row = (int)(it / 424), j = (int)(it % 424);
    const int c0 = j * 8;
    const bfr* pr = PR + (size_t)row * NRW + c0;
    u16x8 p = *(const u16x8*)pr;
    u16x8 nb[4];
    const u16x8 zero = {0, 0, 0, 0, 0, 0, 0, 0};
    if (row < TC) {
      const int t = row & 255;
      nb[0] = (t > 0) ? *(const u16x8*)(pr - NRW) : zero;
      nb[1] = (t < 255) ? *(const u16x8*)(pr + NRW) : zero;
      nb[2] = nb[0]; nb[3] = nb[1];
    } else {
      const int t = (row - TC) & 4095;
      const int gx = t & 63, gy = t >> 6;
      nb[0] = (gx > 0) ? *(const u16x8*)(pr - NRW) : zero;
      nb[1] = (gx < 63) ? *(const u16x8*)(pr + NRW) : zero;
      nb[2] = (gy > 0) ? *(const u16x8*)(pr - (size_t)64 * NRW) : zero;
      nb[3] = (gy < 63) ? *(const u16x8*)(pr + (size_t)64 * NRW) : zero;
    }
    float o[8];
#pragma unroll
    for (int e = 0; e < 8; e++) {
      float pv = b2f(p[e]);
      float sv = b2f(nb[e & 3][e]);
      o[e] = pv + (sv - pv) * mu[c0 + e];
    }
    u16x8 ov;
    if (c0 < 3072) {
#pragma unroll
      for (int e = 0; e < 8; e++) ov[e] = f2b(o[e]);
      const int seg = c0 >> 10, cc = c0 & 1023;
      bfr* dst = (seg == 0) ? R : (seg == 1 ? KP : V);
      *(u16x8*)(dst + (size_t)row * 1024 + cc) = ov;
      if (seg == 2 && l == 0) *(u16x8*)(VF + (size_t)row * 1024 + cc) = ov;
    } else {
      const int cs = c0 - 3072;
#pragma unroll
      for (int e = 0; e < 8; e++) {
        float v = o[e];
        if (cs < 128) v = 1.0f - 2.0f * __builtin_amdgcn_rcpf(1.0f + __expf(2.0f * v));
        else if (cs >= 192) v = sigmoidf_(v);
        ov[e] = f2b(v);
      }
      *(u16x8*)(SM + (size_t)row * 320 + cs) = ov;
    }
  }
}

__device__ __forceinline__ void ret_prep(const Pm& P) {
  bfr* PT = WSP(bfr, OFF_PRET);
  const long nitems = (long)T * 64;
  for (long it = (long)blockIdx.x * NTHR + ftid(); it < nitems; it += (long)gridDim.x * NTHR) {
    const int row = (int)(it >> 6), rem = (int)(it & 63);
    const int h = rem >> 4, i0 = (rem & 15) * 8;
    const float pos = (row < TC) ? (float)(row & 255) : (float)(256 + ((row - TC) & 4095));
    float cs[8], sn[8];
#pragma unroll
    for (int e = 0; e < 8; e++) {
      float invf = exp2f(-(float)(i0 + e) * (13.287712379549449f / 128.0f));
      float ang = pos * invf;
      sincosf(ang, &sn[e], &cs[e]);
    }
#pragma unroll
    for (int qk = 0; qk < 2; qk++) {
      bfr* base = PT + (size_t)row * NRET + qk * 1024 + h * 256 + i0;
      u16x8 t1 = *(u16x8*)base, t2 = *(u16x8*)(base + 128);
      const float scl = qk ? 0.0625f : 1.0f;
      u16x8 o1, o2;
#pragma unroll
      for (int e = 0; e < 8; e++) {
        float a = b2f(t1[e]), b = b2f(t2[e]);
        o1[e] = f2b((a * cs[e] - b * sn[e]) * scl);
        o2[e] = f2b((a * sn[e] + b * cs[e]) * scl);
      }
      *(u16x8*)base = o1;
      *(u16x8*)(base + 128) = o2;
    }
  }
}

#define FMAC_BC(acc, x, s, J) \
  asm("v_fmac_f32_dpp %0, %1, %2 row_newbcast:" #J " row_mask:0xf bank_mask:0xf" : "+v"(acc) : "v"(x), "v"(s))
#define DOT16(o0_, o1_, o2_, o3_, x_) asm("v_mul_f32_dpp %0, %4, %5 row_newbcast:0 row_mask:0xf bank_mask:0xf\n\t" \
  "v_mul_f32_dpp %1, %4, %6 row_newbcast:1 row_mask:0xf bank_mask:0xf\n\t" \
  "v_mul_f32_dpp %2, %4, %7 row_newbcast:2 row_mask:0xf bank_mask:0xf\n\t" \
  "v_mul_f32_dpp %3, %4, %8 row_newbcast:3 row_mask:0xf bank_mask:0xf\n\t" \
  "v_fmac_f32_dpp %0, %4, %9 row_newbcast:4 row_mask:0xf bank_mask:0xf\n\t" \
  "v_fmac_f32_dpp %1, %4, %10 row_newbcast:5 row_mask:0xf bank_mask:0xf\n\t" \
  "v_fmac_f32_dpp %2, %4, %11 row_newbcast:6 row_mask:0xf bank_mask:0xf\n\t" \
  "v_fmac_f32_dpp %3, %4, %12 row_newbcast:7 row_mask:0xf bank_mask:0xf\n\t" \
  "v_fmac_f32_dpp %0, %4, %13 row_newbcast:8 row_mask:0xf bank_mask:0xf\n\t" \
  "v_fmac_f32_dpp %1, %4, %14 row_newbcast:9 row_mask:0xf bank_mask:0xf\n\t" \
  "v_fmac_f32_dpp %2, %4, %15 row_newbcast:10 row_mask:0xf bank_mask:0xf\n\t" \
  "v_fmac_f32_dpp %3, %4, %16 row_newbcast:11 row_mask:0xf bank_mask:0xf\n\t" \
  "v_fmac_f32_dpp %0, %4, %17 row_newbcast:12 row_mask:0xf bank_mask:0xf\n\t" \
  "v_fmac_f32_dpp %1, %4, %18 row_newbcast:13 row_mask:0xf bank_mask:0xf\n\t" \
  "v_fmac_f32_dpp %2, %4, %19 row_newbcast:14 row_mask:0xf bank_mask:0xf\n\t" \
  "v_fmac_f32_dpp %3, %4, %20 row_newbcast:15 row_mask:0xf bank_mask:0xf\n\t" \
  : "=&v"(o0_), "=&v"(o1_), "=&v"(o2_), "=&v"(o3_) \
  : "v"(x_), "v"(S[0]), "v"(S[1]), "v"(S[2]), "v"(S[3]), "v"(S[4]), "v"(S[5]), "v"(S[6]), "v"(S[7]), "v"(S[8]), "v"(S[9]), "v"(S[10]), "v"(S[11]), "v"(S[12]), "v"(S[13]), "v"(S[14]), "v"(S[15]))
#define UPD_A(ne_, kp_, vv_) asm("v_fmac_f32_dpp %0, %16, %0 row_newbcast:0 row_mask:0xf bank_mask:0xf\n\t" \
  "v_fmac_f32_dpp %1, %16, %1 row_newbcast:1 row_mask:0xf bank_mask:0xf\n\t" \
  "v_fmac_f32_dpp %2, %16, %2 row_newbcast:2 row_mask:0xf bank_mask:0xf\n\t" \
  "v_fmac_f32_dpp %3, %16, %3 row_newbcast:3 row_mask:0xf bank_mask:0xf\n\t" \
  "v_fmac_f32_dpp %4, %16, %4 row_newbcast:4 row_mask:0xf bank_mask:0xf\n\t" \
  "v_fmac_f32_dpp %5, %16, %5 row_newbcast:5 row_mask:0xf bank_mask:0xf\n\t" \
  "v_fmac_f32_dpp %6, %16, %6 row_newbcast:6 row_mask:0xf bank_mask:0xf\n\t" \
  "v_fmac_f32_dpp %7, %16, %7 row_newbcast:7 row_mask:0xf bank_mask:0xf\n\t" \
  "v_fmac_f32_dpp %8, %16, %8 row_newbcast:8 row_mask:0xf bank_mask:0xf\n\t" \
  "v_fmac_f32_dpp %9, %16, %9 row_newbcast:9 row_mask:0xf bank_mask:0xf\n\t" \
  "v_fmac_f32_dpp %10, %16, %10 row_newbcast:10 row_mask:0xf bank_mask:0xf\n\t" \
  "v_fmac_f32_dpp %11, %16, %11 row_newbcast:11 row_mask:0xf bank_mask:0xf\n\t" \
  "v_fmac_f32_dpp %12, %16, %12 row_newbcast:12 row_mask:0xf bank_mask:0xf\n\t" \
  "v_fmac_f32_dpp %13, %16, %13 row_newbcast:13 row_mask:0xf bank_mask:0xf\n\t" \
  "v_fmac_f32_dpp %14, %16, %14 row_newbcast:14 row_mask:0xf bank_mask:0xf\n\t" \
  "v_fmac_f32_dpp %15, %16, %15 row_newbcast:15 row_mask:0xf bank_mask:0xf\n\t" \
  "v_fmac_f32_dpp %0, %17, %18 row_newbcast:0 row_mask:0xf bank_mask:0xf\n\t" \
  "v_fmac_f32_dpp %1, %17, %18 row_newbcast:1 row_mask:0xf bank_mask:0xf\n\t" \
  "v_fmac_f32_dpp %2, %17, %18 row_newbcast:2 row_mask:0xf bank_mask:0xf\n\t" \
  "v_fmac_f32_dpp %3, %17, %18 row_newbcast:3 row_mask:0xf bank_mask:0xf\n\t" \
  "v_fmac_f32_dpp %4, %17, %18 row_newbcast:4 row_mask:0xf bank_mask:0xf\n\t" \
  "v_fmac_f32_dpp %5, %17, %18 row_newbcast:5 row_mask:0xf bank_mask:0xf\n\t" \
  "v_fmac_f32_dpp %6, %17, %18 row_newbcast:6 row_mask:0xf bank_mask:0xf\n\t" \
  "v_fmac_f32_dpp %7, %17, %18 row_newbcast:7 row_mask:0xf bank_mask:0xf\n\t" \
  "v_fmac_f32_dpp %8, %17, %18 row_newbcast:8 row_mask:0xf bank_mask:0xf\n\t" \
  "v_fmac_f32_dpp %9, %17, %18 row_newbcast:9 row_mask:0xf bank_mask:0xf\n\t" \
  "v_fmac_f32_dpp %10, %17, %18 row_newbcast:10 row_mask:0xf bank_mask:0xf\n\t" \
  "v_fmac_f32_dpp %11, %17, %18 row_newbcast:11 row_mask:0xf bank_mask:0xf\n\t" \
  "v_fmac_f32_dpp %12, %17, %18 row_newbcast:12 row_mask:0xf bank_mask:0xf\n\t" \
  "v_fmac_f32_dpp %13, %17, %18 row_newbcast:13 row_mask:0xf bank_mask:0xf\n\t" \
  "v_fmac_f32_dpp %14, %17, %18 row_newbcast:14 row_mask:0xf bank_mask:0xf\n\t" \
  "v_fmac_f32_dpp %15, %17, %18 row_newbcast:15 row_mask:0xf bank_mask:0xf\n\t" \
  : "+v"(S[0]), "+v"(S[1]), "+v"(S[2]), "+v"(S[3]), "+v"(S[4]), "+v"(S[5]), "+v"(S[6]), "+v"(S[7]), "+v"(S[8]), "+v"(S[9]), "+v"(S[10]), "+v"(S[11]), "+v"(S[12]), "+v"(S[13]), "+v"(S[14]), "+v"(S[15]) \
  : "v"(ne_), "v"(kp_), "v"(vv_))
#define UPD_B(nkka_, sa_) asm("v_fmac_f32_dpp %0, %16, %17 row_newbcast:0 row_mask:0xf bank_mask:0xf\n\t" \
  "v_fmac_f32_dpp %1, %16, %17 row_newbcast:1 row_mask:0xf bank_mask:0xf\n\t" \
  "v_fmac_f32_dpp %2, %16, %17 row_newbcast:2 row_mask:0xf bank_mask:0xf\n\t" \
  "v_fmac_f32_dpp %3, %16, %17 row_newbcast:3 row_mask:0xf bank_mask:0xf\n\t" \
  "v_fmac_f32_dpp %4, %16, %17 row_newbcast:4 row_mask:0xf bank_mask:0xf\n\t" \
  "v_fmac_f32_dpp %5, %16, %17 row_newbcast:5 row_mask:0xf bank_mask:0xf\n\t" \
  "v_fmac_f32_dpp %6, %16, %17 row_newbcast:6 row_mask:0xf bank_mask:0xf\n\t" \
  "v_fmac_f32_dpp %7, %16, %17 row_newbcast:7 row_mask:0xf bank_mask:0xf\n\t" \
  "v_fmac_f32_dpp %8, %16, %17 row_newbcast:8 row_mask:0xf bank_mask:0xf\n\t" \
  "v_fmac_f32_dpp %9, %16, %17 row_newbcast:9 row_mask:0xf bank_mask:0xf\n\t" \
  "v_fmac_f32_dpp %10, %16, %17 row_newbcast:10 row_mask:0xf bank_mask:0xf\n\t" \
  "v_fmac_f32_dpp %11, %16, %17 row_newbcast:11 row_mask:0xf bank_mask:0xf\n\t" \
  "v_fmac_f32_dpp %12, %16, %17 row_newbcast:12 row_mask:0xf bank_mask:0xf\n\t" \
  "v_fmac_f32_dpp %13, %16, %17 row_newbcast:13 row_mask:0xf bank_mask:0xf\n\t" \
  "v_fmac_f32_dpp %14, %16, %17 row_newbcast:14 row_mask:0xf bank_mask:0xf\n\t" \
  "v_fmac_f32_dpp %15, %16, %17 row_newbcast:15 row_mask:0xf bank_mask:0xf\n\t" \
  : "+v"(S[0]), "+v"(S[1]), "+v"(S[2]), "+v"(S[3]), "+v"(S[4]), "+v"(S[5]), "+v"(S[6]), "+v"(S[7]), "+v"(S[8]), "+v"(S[9]), "+v"(S[10]), "+v"(S[11]), "+v"(S[12]), "+v"(S[13]), "+v"(S[14]), "+v"(S[15]) \
  : "v"(nkka_), "v"(sa_))
#define REP16(M) M(0) M(1) M(2) M(3) M(4) M(5) M(6) M(7) M(8) M(9) M(10) M(11) M(12) M(13) M(14) M(15)
__device__ __forceinline__ float rowsum4(float x) {
  float a = x, b = x;
  asm volatile("s_nop 1\n\tv_permlane32_swap_b32 %0, %1" : "+v"(a), "+v"(b));
  float s = a + b;
  float c = s, d = s;
  asm volatile("s_nop 1\n\tv_permlane16_swap_b32 %0, %1" : "+v"(c), "+v"(d));
  return c + d;
}
__device__ __forceinline__ int seq_row(int p, int b, int dir) {
  if (p < 256) return b * 256 + (dir ? 255 - p : p);
  int q = p - 256;
  return TC + b * 4096 + (dir ? 4095 - q : q);
}
__device__ __forceinline__ void rwkv_scan(const Pm& P, int unit, char* smem) {
  const int tid = ftid(), wid = tid >> 6, lane = tid & 63;
  const int b = unit >> 5, h = (unit >> 1) & 15, dir = unit & 1;
  const bfr* S7b = WSP(bfr, OFF_S7);
  bfr* O = dir ? WSP(bfr, OFF_OB) : WSP(bfr, OFF_OF);
  constexpr int CHB = 64 * 6 * 64 * 2;
  const int colv = h * 64 + (wid & 3) * 16 + (lane & 15);
  float S[16];
#pragma unroll
  for (int j = 0; j < 16; j++) S[j] = 0.f;
  const int lt = tid - 256;
  auto load_chunk = [&](int c, char* buf) {
#pragma unroll
    for (int i = 0; i < 12; i++) {
      const int idx = lt + 256 * i;
      const int step = idx / 48, rem = idx - step * 48;
      const int arr = rem >> 3, part = rem & 7;
      const int am = (arr == 0) ? 0 : (arr == 1) ? 1 : (arr == 2) ? 3 : (arr == 3) ? 4 : (arr == 4) ? (5 + dir) : 2;
      const bfr* src = S7b + (size_t)am * ((size_t)T * 1024) + (size_t)seq_row(c * 64 + step, b, dir) * 1024 + h * 64 + part * 8;
      __builtin_amdgcn_global_load_lds((const unsigned*)src, (unsigned*)(buf + idx * 16), 16, 0, 0);
    }
  };
  __syncthreads();
  if (wid >= 4) {
    load_chunk(0, smem);
    asm volatile("s_waitcnt vmcnt(0)" ::: "memory");
  }
  __syncthreads();
  for (int c = 0; c < 68; c++) {
    if (wid >= 4) {
      if (c + 1 < 68) load_chunk(c + 1, smem + ((c + 1) & 1) * CHB);
      asm volatile("s_waitcnt vmcnt(0)" ::: "memory");
    } else {
      const bfr* buf = (const bfr*)(smem + (c & 1) * CHB);
      const int q_ = lane >> 4;
      const int rbase_c = seq_row(c * 64, b, dir);
      const int sgn = dir ? -1 : 1;
      bfr* Oq = O + (size_t)(rbase_c + sgn * q_) * 1024 + colv;
      auto ld = [&](int s, bfr (&x)[6]) {
        const bfr* sp = buf + s * 384;
        x[0] = sp[lane]; x[1] = sp[64 + lane]; x[2] = sp[128 + lane]; x[3] = sp[192 + lane]; x[4] = sp[256 + lane];
        x[5] = sp[320 + wid * 16 + (lane & 15)];
      };
      auto group = [&](bfr (&X)[4][6], int s) {
        float op[4];
#pragma unroll
        for (int u = 0; u < 4; u++) {
          float r = b2f(X[u][0]), kp = b2f(X[u][1]), kk = b2f(X[u][2]), nkka = b2f(X[u][3]), ne = b2f(X[u][4]), vv = b2f(X[u][5]);
          asm volatile("s_nop 1" : "+v"(kk), "+v"(nkka), "+v"(ne), "+v"(kp), "+v"(r));
          float sa0, sa1, sa2, sa3;
          DOT16(sa0, sa1, sa2, sa3, kk);
          UPD_A(ne, kp, vv);
          float sa = rowsum4((sa0 + sa1) + (sa2 + sa3));
          UPD_B(nkka, sa);
          float o0, o1, o2, o3;
          DOT16(o0, o1, o2, o3, r);
          op[u] = (o0 + o1) + (o2 + o3);
        }
        float a_ = op[0], c_ = op[2], b_ = op[1], d_ = op[3];
        asm volatile("s_nop 1\n\tv_permlane32_swap_b32 %0, %1" : "+v"(a_), "+v"(c_));
        asm volatile("s_nop 1\n\tv_permlane32_swap_b32 %0, %1" : "+v"(b_), "+v"(d_));
        float s02 = a_ + c_, s13 = b_ + d_;
        asm volatile("s_nop 1\n\tv_permlane16_swap_b32 %0, %1" : "+v"(s02), "+v"(s13));
        const float tot = s02 + s13;
        Oq[(ptrdiff_t)sgn * s * 1024] = f2b(tot);
      };
      bfr XA[4][6], XB[4][6];
#pragma unroll
      for (int u = 0; u < 4; u++) ld(u, XA[u]);
      for (int s0 = 0; s0 < 64; s0 += 8) {
#pragma unroll
        for (int u = 0; u < 4; u++) ld(s0 + 4 + u, XB[u]);
        group(XA, s0);
        if (s0 + 8 < 64) {
#pragma unroll
          for (int u = 0; u < 4; u++) ld(s0 + 8 + u, XA[u]);
        }
        group(XB, s0 + 4);
      }
    }
    __syncthreads();
  }
}

__device__ __forceinline__ void rwkv_scan_simple(const Pm& P, int unit) {
  const int tid = ftid();
  const int b = unit >> 5, h = (unit >> 1) & 15, dir = unit & 1;
  const bfr* R = WSP(bfr, OFF_R); const bfr* KP = WSP(bfr, OFF_KP); const bfr* V = WSP(bfr, OFF_V);
  const bfr* KKN = WSP(bfr, OFF_KKN); const bfr* AA = WSP(bfr, OFF_AA);
  const bfr* NE = dir ? WSP(bfr, OFF_NEB) : WSP(bfr, OFF_NEF);
  bfr* O = dir ? WSP(bfr, OFF_OB) : WSP(bfr, OFF_OF);
  const int v = tid >> 3, kq = tid & 7;
  float S[8];
#pragma unroll
  for (int j = 0; j < 8; j++) S[j] = 0.f;
  for (int p = 0; p < 4352; p++) {
    const size_t rw = (size_t)seq_row(p, b, dir) * 1024 + h * 64;
    const size_t ro = rw + kq * 8;
    u16x8 r8 = *(const u16x8*)(R + ro), kp8 = *(const u16x8*)(KP + ro), kk8 = *(const u16x8*)(KKN + ro);
    u16x8 aa8 = *(const u16x8*)(AA + ro), ne8 = *(const u16x8*)(NE + ro);
    const float vv = b2f(V[rw + v]);
    float sa = 0.f;
#pragma unroll
    for (int j = 0; j < 8; j++) sa += S[j] * b2f(kk8[j]);
    sa += __shfl_xor(sa, 1); sa += __shfl_xor(sa, 2); sa += __shfl_xor(sa, 4);
    float o = 0.f;
#pragma unroll
    for (int j = 0; j < 8; j++) {
      S[j] = S[j] + b2f(ne8[j]) * S[j] + sa * b2f(aa8[j]) + vv * b2f(kp8[j]);
      o += S[j] * b2f(r8[j]);
    }
    o += __shfl_xor(o, 1); o += __shfl_xor(o, 2); o += __shfl_xor(o, 4);
    if (kq == 0) O[rw + v] = f2b(o);
  }
}

constexpr int QS = 136;
constexpr int TS = 72;
__device__ __forceinline__ void gla_prep(const Pm& P, int l) {
  const bfr* PG = WSP(bfr, OFF_PGLA);
  unsigned short* CUM = WSP(unsigned short, OFF_CUM);
  const int nitems = 272 * 1024;
  for (int it = blockIdx.x * NTHR + ftid(); it < nitems; it += gridDim.x * NTHR) {
    const int c = it >> 10, col = it & 1023, dir = col >> 9, dd = col & 511;
    float a2c[16];
#pragma unroll
    for (int r = 0; r < 16; r++) a2c[r] = P.in[I_GA2][(((size_t)l * 2 + dir) * 16 + r) * 512 + dd];
    const float ab = P.in[I_GAB][((size_t)l * 2 + dir) * 512 + dd];
    float run = 0.f;
    for (int i = 0; i < 64; i++) {
      const int row = dir ? (64 * c + 63 - i) : (64 * c + i);
      const bfr* adp = PG + (size_t)row * NGLA + 3072 + dir * 16;
      u16x8 a0 = *(const u16x8*)adp, a1 = *(const u16x8*)(adp + 8);
      float x = ab;
#pragma unroll
      for (int r = 0; r < 8; r++) { x += b2f(a0[r]) * a2c[r]; x += b2f(a1[r]) * a2c[8 + r]; }
      const float lg = (fminf(x, 0.f) - __logf(1.0f + __expf(-fabsf(x)))) * (1.0f / 16.0f);
      run += lg;
      _Float16 hv = (_Float16)run;
      CUM[(size_t)row * 1024 + col] = __builtin_bit_cast(unsigned short, hv);
    }
  }
}
__device__ __forceinline__ float h2f(unsigned short u) { return (float)__builtin_bit_cast(_Float16, u); }

template <int NS>
__device__ __forceinline__ void chunk_scan(const Pm& P, int l, int unit, char* smem) {
  const int tid = ftid(), w = tid >> 6, lane = tid & 63, fr = lane & 15, fq = lane >> 4;
  const int b = unit >> 4, h = (unit >> 2) & 3, slice = unit & 3;
  constexpr int DK = 128 * NS;
  const bfr* Pb = (NS == 1) ? WSP(bfr, OFF_PGLA) : WSP(bfr, OFF_PRET);
  const unsigned short* CUM = WSP(unsigned short, OFF_CUM);
  constexpr int ldp = (NS == 1) ? NGLA : NRET;
  const int qoff = h * DK, koff = ((NS == 1) ? 512 : 1024) + h * DK;
  const int voff = ((NS == 1) ? 1024 : 2048) + h * 256 + slice * 64;
  bfr* O = (NS == 1) ? WSP(bfr, OFF_OGLA) : WSP(bfr, OFF_ORET);
  const int ocol = h * 256 + slice * 64;
  const float qscale = (NS == 1) ? 0.08838834764831845f : 1.0f;

  bfr* Qi = (bfr*)smem;
  bfr* Ki = (bfr*)(smem + 17408);
  bfr* KoT = (bfr*)(smem + 34816);
  bfr* VT = (bfr*)(smem + 53248);
  bfr* Pm_ = (bfr*)(smem + 62464);
  bfr* ST = (bfr*)(smem + 71680);
  float* lastv = (float*)(smem + 71680 + NS * 17408);

  const int d = tid & 127, tq = tid >> 7;
  const int t2 = tid >> 4, db = tid & 15;
  const int vc = tid & 63, tg = tid >> 6;
  const int mt = w >> 1, nb = (w & 1) * 2;

  for (int dir = 0; dir < 2; dir++) {
    const int sgn = dir ? -1 : 1;
    auto rbase_of = [&](int n) {
      if (n < 4) return dir ? (b * 256 + 255 - 64 * n) : (b * 256 + 64 * n);
      return dir ? (TC + b * 4096 + 4095 - 64 * (n - 4)) : (TC + b * 4096 + 64 * (n - 4));
    };
    f32x4 acc_st[NS][4];
#pragma unroll
    for (int s = 0; s < NS; s++)
#pragma unroll
      for (int v = 0; v < 4; v++) acc_st[s][v] = f32x4{0.f, 0.f, 0.f, 0.f};
    __syncthreads();
    for (int e = tid; e < NS * 64 * QS; e += NTHR) ST[e] = 0;
    float lgam = 0.f;
    if (NS == 2) lgam = -__expf(P.in[I_RDEC][((size_t)l * 2 + dir) * 4 + h]);
    const u16x8 z8 = {0, 0, 0, 0, 0, 0, 0, 0};
    u16x8 pq8[2], pk8[2], pc8[2];
    bfr pv[8], po_next[8], po_cur[8];
    unsigned short plast = 0;
    pq8[0] = pq8[1] = pk8[0] = pk8[1] = pc8[0] = pc8[1] = z8;
#pragma unroll
    for (int i = 0; i < 8; i++) { pv[i] = 0; po_next[i] = 0; po_cur[i] = 0; }
    auto issue = [&](int n, int s) {
      const int rb = rbase_of(n);
      if (s == 0) {
#pragma unroll
        for (int i = 0; i < 8; i++) pv[i] = Pb[(size_t)(rb + sgn * (8 * tg + i)) * ldp + voff + vc];
        if (NS == 1 && tid < 128) plast = CUM[(size_t)(rb + sgn * 63) * 1024 + dir * 512 + h * 128 + tid];
        if (dir) {
#pragma unroll
          for (int j = 0; j < 2; j++)
#pragma unroll
            for (int jj = 0; jj < 4; jj++)
              po_next[j * 4 + jj] = O[(size_t)(rb + sgn * (16 * mt + fq * 4 + jj)) * 1024 + ocol + 16 * (nb + j) + fr];
        }
      }
#pragma unroll
      for (int i = 0; i < 2; i++) {
        const int row = rb + sgn * (t2 + 32 * i);
        const size_t ro = (size_t)row * ldp;
        pq8[i] = *(const u16x8*)(Pb + ro + qoff + s * 128 + db * 8);
        pk8[i] = *(const u16x8*)(Pb + ro + koff + s * 128 + db * 8);
        if (NS == 1) pc8[i] = *(const u16x8*)(CUM + (size_t)row * 1024 + dir * 512 + h * 128 + db * 8);
      }
    };
    issue(0, 0);
    for (int n = 0; n < 68; n++) {
      const int rbase = rbase_of(n);
      __syncthreads();
      {
        u16x8 vv;
#pragma unroll
        for (int i = 0; i < 8; i++) vv[i] = pv[i];
        *(u16x8*)(VT + vc * TS + 8 * tg) = vv;
      }
#pragma unroll
      for (int i = 0; i < 8; i++) po_cur[i] = po_next[i];
      f32x4 acc_s[2], acc_o[2];
      acc_s[0] = acc_s[1] = acc_o[0] = acc_o[1] = f32x4{0.f, 0.f, 0.f, 0.f};
#pragma unroll
      for (int s = 0; s < NS; s++) {
        if (NS == 1) {
          if (tid < 128) lastv[tid] = h2f(plast);
        } else {
          if (tid < 128) lastv[s * 128 + tid] = 64.0f * lgam;
        }
#pragma unroll
        for (int i = 0; i < 2; i++) {
          const int t = t2 + 32 * i;
          u16x8 qo, ko;
          if (NS == 1) {
#pragma unroll
            for (int e = 0; e < 8; e++) {
              const float c = h2f(pc8[i][e]);
              qo[e] = f2b(b2f(pq8[i][e]) * qscale * __expf(c));
              ko[e] = f2b(b2f(pk8[i][e]) * __expf(-c));
            }
          } else {
            const float c = (float)(t + 1) * lgam;
            const float eq = __expf(c), ek = __expf(-c);
#pragma unroll
            for (int e = 0; e < 8; e++) {
              qo[e] = f2b(b2f(pq8[i][e]) * eq);
              ko[e] = f2b(b2f(pk8[i][e]) * ek);
            }
          }
          *(u16x8*)(Qi + t * QS + db * 8) = qo;
          *(u16x8*)(Ki + t * QS + db * 8) = ko;
        }
        if (s + 1 < NS) issue(n, s + 1);
        else if (n + 1 < 68) issue(n + 1, 0);
        __syncthreads();
        {
          u16x8 k0, k1;
#pragma unroll
          for (int i = 0; i < 8; i++) { k0[i] = Ki[(16 * tq + i) * QS + d]; k1[i] = Ki[(16 * tq + 8 + i) * QS + d]; }
          *(u16x8*)(KoT + d * TS + 16 * tq) = k0;
          *(u16x8*)(KoT + d * TS + 16 * tq + 8) = k1;
        }
#pragma unroll
        for (int kk = 0; kk < 4; kk++) {
          bf16x8 a = *(const bf16x8*)(Qi + (16 * mt + fr) * QS + kk * 32 + fq * 8);
#pragma unroll
          for (int j = 0; j < 2; j++) {
            const int nt = nb + j;
            if (nt <= mt) {
              bf16x8 bb = *(const bf16x8*)(Ki + (16 * nt + fr) * QS + kk * 32 + fq * 8);
              acc_s[j] = __builtin_amdgcn_mfma_f32_16x16x32_bf16(a, bb, acc_s[j], 0, 0, 0);
            }
            bf16x8 sb = *(const bf16x8*)(ST + s * 64 * QS + (16 * nt + fr) * QS + kk * 32 + fq * 8);
            acc_o[j] = __builtin_amdgcn_mfma_f32_16x16x32_bf16(a, sb, acc_o[j], 0, 0, 0);
          }
        }
        __syncthreads();
        {
#pragma unroll
          for (int kk = 0; kk < 2; kk++) {
            bf16x8 bb = *(const bf16x8*)(KoT + (16 * w + fr) * TS + kk * 32 + fq * 8);
#pragma unroll
            for (int vt = 0; vt < 4; vt++) {
              bf16x8 a = *(const bf16x8*)(VT + (16 * vt + fr) * TS + kk * 32 + fq * 8);
              acc_st[s][vt] = __builtin_amdgcn_mfma_f32_16x16x32_bf16(a, bb, acc_st[s][vt], 0, 0, 0);
            }
          }
          const float dec = __expf(lastv[s * 128 + 16 * w + fr]);
#pragma unroll
          for (int vt = 0; vt < 4; vt++) acc_st[s][vt] *= dec;
        }
        __syncthreads();
#pragma unroll
        for (int vt = 0; vt < 4; vt++)
#pragma unroll
          for (int j = 0; j < 4; j++) ST[s * 64 * QS + (16 * vt + fq * 4 + j) * QS + 16 * w + fr] = f2b(acc_st[s][vt][j]);
      }
#pragma unroll
      for (int j = 0; j < 2; j++) {
        const int nt = nb + j;
#pragma unroll
        for (int jj = 0; jj < 4; jj++) {
          const int t = 16 * mt + fq * 4 + jj, sc = 16 * nt + fr;
          float val = (sc <= t) ? acc_s[j][jj] : 0.f;
          Pm_[t * TS + sc] = f2b(val);
        }
      }
      __syncthreads();
#pragma unroll
      for (int kk = 0; kk < 2; kk++) {
        bf16x8 a = *(const bf16x8*)(Pm_ + (16 * mt + fr) * TS + kk * 32 + fq * 8);
#pragma unroll
        for (int j = 0; j < 2; j++) {
          bf16x8 bb = *(const bf16x8*)(VT + (16 * (nb + j) + fr) * TS + kk * 32 + fq * 8);
          acc_o[j] = __builtin_amdgcn_mfma_f32_16x16x32_bf16(a, bb, acc_o[j], 0, 0, 0);
        }
      }
#pragma unroll
      for (int j = 0; j < 2; j++)
#pragma unroll
        for (int jj = 0; jj < 4; jj++) {
          const int t = 16 * mt + fq * 4 + jj;
          bfr* addr = O + (size_t)(rbase + sgn * t) * 1024 + ocol + 16 * (nb + j) + fr;
          float val = acc_o[j][jj];
          if (dir) val += b2f(po_cur[j * 4 + jj]);
          *addr = f2b(val);
        }
    }
  }
}

__device__ __forceinline__ void finish(const Pm& P, int l) {
  const int tid_ = ftid();
  const int lane = tid_ & 63, wid = tid_ >> 6;
  const int c0 = lane * 16;
  bfr* OF = WSP(bfr, OFF_OF); const bfr* OB = WSP(bfr, OFF_OB); const bfr* G = WSP(bfr, OFF_G);
  const bfr* R = WSP(bfr, OFF_R); const bfr* KP = WSP(bfr, OFF_KP); const bfr* V = WSP(bfr, OFF_V);
  bfr* OG = WSP(bfr, OFF_OGLA); bfr* OR_ = WSP(bfr, OFF_ORET);
  const bfr* PGL = WSP(bfr, OFF_PGLA); const bfr* PRT = WSP(bfr, OFF_PRET);
  const float* lng = P.in[I_LNG] + (size_t)l * 1024 + c0; const float* lnb = P.in[I_LNB] + (size_t)l * 1024 + c0;
  const float* rk = P.in[I_RK] + (size_t)l * 1024 + c0;
  const float* gng = P.in[I_GNG] + (size_t)l * 1024 + c0; const float* rng = P.in[I_RNG] + (size_t)l * 1024 + c0;
  for (int row = blockIdx.x * 8 + wid; row < T; row += gridDim.x * 8) {
    const size_t ro = (size_t)row * 1024 + c0;
    {
      float o[16], rr[16], kk[16], vv[16], gg[16];
#pragma unroll
      for (int hh = 0; hh < 2; hh++) {
        u16x8 a = *(const u16x8*)(OF + ro + hh * 8), bq = *(const u16x8*)(OB + ro + hh * 8);
        u16x8 r8 = *(const u16x8*)(R + ro + hh * 8), k8 = *(const u16x8*)(KP + ro + hh * 8), v8 = *(const u16x8*)(V + ro + hh * 8);
        u16x8 g8 = *(const u16x8*)(G + ro + hh * 8);
#pragma unroll
        for (int e = 0; e < 8; e++) {
          o[hh * 8 + e] = b2f(a[e]) + b2f(bq[e]);
          rr[hh * 8 + e] = b2f(r8[e]); kk[hh * 8 + e] = b2f(k8[e]); vv[hh * 8 + e] = b2f(v8[e]); gg[hh * 8 + e] = b2f(g8[e]);
        }
      }
      float s1 = 0.f, sb = 0.f;
#pragma unroll
      for (int i = 0; i < 16; i++) { s1 += o[i]; sb += rr[i] * kk[i] * rk[i]; }
      s1 += __shfl_xor(s1, 1); s1 += __shfl_xor(s1, 2);
      sb += __shfl_xor(sb, 1); sb += __shfl_xor(sb, 2);
      const float mean = s1 * (1.0f / 64.0f);
      float s2 = 0.f;
#pragma unroll
      for (int i = 0; i < 16; i++) { o[i] -= mean; s2 += o[i] * o[i]; }
      s2 += __shfl_xor(s2, 1); s2 += __shfl_xor(s2, 2);
      const float rs = rsqrtf(s2 * (1.0f / 64.0f) + 64e-5f);
      u16x8 w0, w1;
#pragma unroll
      for (int i = 0; i < 16; i++) {
        float y = o[i] * rs * lng[i] + lnb[i];
        bfr ov = f2b((y + sb * vv[i]) * gg[i]);
        if (ZERO_BRANCH == 1) ov = 0;
        if (i < 8) w0[i] = ov; else w1[i - 8] = ov;
      }
      *(u16x8*)(OF + ro) = w0; *(u16x8*)(OF + ro + 8) = w1;
    }
#pragma unroll
    for (int mx = 0; mx < 2; mx++) {
      bfr* Ob = mx ? OR_ : OG;
      const bfr* gsrc = mx ? (PRT + (size_t)row * NRET + 3072 + c0) : (PGL + (size_t)row * NGLA + 2048 + c0);
      const float* ng = mx ? rng : gng;
      float o[16], gt[16];
#pragma unroll
      for (int hh = 0; hh < 2; hh++) {
        u16x8 a = *(const u16x8*)(Ob + ro + hh * 8), g8 = *(const u16x8*)(gsrc + hh * 8);
#pragma unroll
        for (int e = 0; e < 8; e++) { o[hh * 8 + e] = b2f(a[e]); gt[hh * 8 + e] = b2f(g8[e]); }
      }
      if (mx) {
        float s1 = 0.f;
#pragma unroll
        for (int i = 0; i < 16; i++) s1 += o[i];
        s1 += __shfl_xor(s1, 1); s1 += __shfl_xor(s1, 2); s1 += __shfl_xor(s1, 4); s1 += __shfl_xor(s1, 8);
        const float mean = s1 * (1.0f / 256.0f);
#pragma unroll
        for (int i = 0; i < 16; i++) o[i] -= mean;
      }
      float s2 = 0.f;
#pragma unroll
      for (int i = 0; i < 16; i++) s2 += o[i] * o[i];
      s2 += __shfl_xor(s2, 1); s2 += __shfl_xor(s2, 2); s2 += __shfl_xor(s2, 4); s2 += __shfl_xor(s2, 8);
      const float rs = rsqrtf(s2 * (1.0f / 256.0f) + 1e-5f);
      u16x8 w0, w1;
#pragma unroll
      for (int i = 0; i < 16; i++) {
        bfr ov = f2b(o[i] * rs * ng[i] * siluf_(gt[i]));
        if (ZERO_BRANCH == 2 + mx) ov = 0;
        if (i < 8) w0[i] = ov; else w1[i - 8] = ov;
      }
      *(u16x8*)(Ob + ro) = w0; *(u16x8*)(Ob + ro + 8) = w1;
    }
  }
}


constexpr int STAGE256 = 65536;
__device__ __forceinline__ void gemm256_stage(const bfr* __restrict__ A, int lda, const bfr* __restrict__ Bt, int ldb, int row0,
                                              int col0, int k0, char* st, int tid) {
#pragma unroll
  for (int s = 0; s < 2; s++) {
#pragma unroll
    for (int i = 0; i < 2; i++) {
      int c = tid + i * NTHR;
      int r = c >> 2, kc = (((c & 3) ^ ((0x1320 >> (r & 12)) & 3))) * 8;
      __builtin_amdgcn_global_load_lds((const unsigned*)(A + (size_t)(row0 + r) * lda + k0 + s * 32 + kc),
                                       (unsigned*)(st + s * 16384 + c * 16), 16, 0, 0);
      __builtin_amdgcn_global_load_lds((const unsigned*)(Bt + (size_t)(col0 + r) * ldb + k0 + s * 32 + kc),
                                       (unsigned*)(st + 32768 + s * 16384 + c * 16), 16, 0, 0);
    }
  }
}
__device__ __forceinline__ void gemm256_compute(const char* st, f32x4 (&acc)[8][4], int wr, int wc, int fr, int fq) {
  const int fqs = fq ^ ((0x1320 >> (fr & 12)) & 3);
#pragma unroll
  for (int s = 0; s < 2; s++) {
    bf16x8 b[4];
#pragma unroll
    for (int n = 0; n < 4; n++) b[n] = *(const bf16x8*)(st + 32768 + s * 16384 + ((wc * 64 + n * 16 + fr) * 32 + fqs * 8) * 2);
#pragma unroll
    for (int mh = 0; mh < 2; mh++) {
      bf16x8 a[4];
#pragma unroll
      for (int m = 0; m < 4; m++) a[m] = *(const bf16x8*)(st + s * 16384 + ((wr * 128 + mh * 64 + m * 16 + fr) * 32 + fqs * 8) * 2);
      __builtin_amdgcn_sched_barrier(0);
#pragma unroll
      for (int m = 0; m < 4; m++)
#pragma unroll
        for (int n = 0; n < 4; n++) acc[mh * 4 + m][n] = __builtin_amdgcn_mfma_f32_16x16x32_bf16(a[m], b[n], acc[mh * 4 + m][n], 0, 0, 0);
      __builtin_amdgcn_sched_barrier(0);
    }
  }
}
template <class Epi>
__device__ __forceinline__ void gemm_phase256(const bfr* A, int lda, const bfr* Bt, int ldb, int M, int N, int K, const Epi& epi,
                                              char* smem) {
  const int nM = M >> 8, nN = N >> 8, nk = K >> 6;
  const int tid = ftid(), wid = tid >> 6, lane = tid & 63;
  const int wr = wid >> 2, wc = wid & 3, fr = lane & 15, fq = lane >> 4;
  bool pre = false;
  for (int tile = blockIdx.x; tile < nM * nN; tile += gridDim.x) {
    int mt, nt;
    tile_map(tile, nM, nN, mt, nt);
    f32x4 acc[8][4];
#pragma unroll
    for (int m = 0; m < 8; m++)
#pragma unroll
      for (int n = 0; n < 4; n++) acc[m][n] = f32x4{0.f, 0.f, 0.f, 0.f};
    if (!pre) gemm256_stage(A, lda, Bt, ldb, mt * 256, nt * 256, 0, smem, tid);
#pragma unroll 1
    for (int kt = 0; kt < nk; kt++) {
      asm volatile("s_waitcnt vmcnt(0)" ::: "memory");
      __syncthreads();
      if (kt + 1 < nk) gemm256_stage(A, lda, Bt, ldb, mt * 256, nt * 256, (kt + 1) * 64, smem + ((kt + 1) & 1) * STAGE256, tid);
      gemm256_compute(smem + (kt & 1) * STAGE256, acc, wr, wc, fr, fq);
    }
    __syncthreads();
    pre = false;
    if (tile + (int)gridDim.x < nM * nN) {
      int mt2, nt2;
      tile_map(tile + (int)gridDim.x, nM, nN, mt2, nt2);
      gemm256_stage(A, lda, Bt, ldb, mt2 * 256, nt2 * 256, 0, smem, tid);
      pre = true;
    }
#pragma unroll
    for (int hh = 0; hh < 2; hh++) {
      f32x4 part[4][4];
#pragma unroll
      for (int m = 0; m < 4; m++)
#pragma unroll
        for (int n = 0; n < 4; n++) part[m][n] = acc[hh * 4 + m][n];
      epi(part, mt * 256 + wr * 128 + hh * 64, nt * 256 + wc * 64, fr, fq);
    }
  }
}

#define XB_TMO      128
#define XB_XCNT(j)  (256  + 64 * (j))
#define XB_XSUB(j)  (1280 + 64 * (j))
#define XB_XGEN(j)  (2304 + 64 * (j))
#define XB_TOP      3328
#define XB_TOPGEN   3392
#define XCD_BAR_WORDS 3456
#define XB_SPIN_CAP (1u << 18)
#define LAS __attribute__((address_space(3)))

__device__ __forceinline__ unsigned xb_ld(unsigned* p)              { return __hip_atomic_load(p, __ATOMIC_RELAXED, __HIP_MEMORY_SCOPE_AGENT); }
__device__ __forceinline__ unsigned xb_add(unsigned* p, unsigned v) { return __hip_atomic_fetch_add(p, v, __ATOMIC_RELAXED, __HIP_MEMORY_SCOPE_AGENT); }
__device__ __forceinline__ unsigned xb_xcc_id() { return (unsigned)__builtin_amdgcn_s_getreg((3 << 11) | 20) & 0xFu; }
#define XB_SPIN(cond, bar) do { unsigned _sp = 0; while (cond) { __builtin_amdgcn_s_sleep(1); \
    if ((++_sp & 255u) == 0u) { if (xb_ld(&(bar)[XB_TMO])) break; if (_sp > XB_SPIN_CAP) { atomicAdd(&(bar)[XB_TMO], 1u); break; } } } } while (0)

struct XcdBarrier {
    unsigned* bar; unsigned x;
    volatile LAS unsigned* st;
};

__device__ __forceinline__ XcdBarrier xcd_barrier_post(unsigned* bar, volatile LAS unsigned* st) {
    XcdBarrier b; b.bar = bar; b.x = xb_xcc_id(); b.st = st;
    if (threadIdx.x == 0) (void)xb_add(&bar[XB_XCNT(b.x)], 1u);
    return b;
}
__device__ __forceinline__ void xcd_barrier_complete(unsigned* bar, unsigned x, unsigned& nloc, unsigned& nx) {
    const unsigned G = gridDim.x * gridDim.y * gridDim.z;
    unsigned sum, cnt, mine, sp = 0u;
    for (;;) {
        sum = 0u; cnt = 0u; mine = 0u;
#pragma unroll
        for (unsigned j = 0; j < 16; ++j) { const unsigned c = xb_ld(&bar[XB_XCNT(j)]); sum += c; cnt += (c > 0u) ? 1u : 0u; mine = (j == x) ? c : mine; }
        if (sum == G) break;
        __builtin_amdgcn_s_sleep(1);
        if ((++sp & 255u) == 0u) { if (xb_ld(&bar[XB_TMO])) break; if (sp > XB_SPIN_CAP) { atomicAdd(&bar[XB_TMO], 1u); break; } }
    }
    nloc = mine > 0u ? mine : 1u; nx = cnt > 0u ? cnt : 1u;
}

__device__ __forceinline__ void xcd_barrier(const XcdBarrier& b) {
    asm volatile("s_waitcnt vmcnt(0)" ::: "memory");
    __syncthreads();
    if (threadIdx.x == 0) {
        unsigned* bar = b.bar;
        __builtin_amdgcn_s_waitcnt(0);
        unsigned nloc = b.st[0], nx = b.st[1];
        if (nloc == 0u) { xcd_barrier_complete(bar, b.x, nloc, nx); b.st[0] = nloc; b.st[1] = nx; }
        const unsigned old = xb_add(&bar[XB_XSUB(b.x)], 1u);
        const unsigned gen = old / nloc;
        if (old + 1u == (gen + 1u) * nloc) {
            __builtin_amdgcn_fence(__ATOMIC_RELEASE, "agent");
            asm volatile("s_waitcnt vmcnt(0)" ::: "memory");
            const unsigned og = xb_add(&bar[XB_TOP], 1u);
            const unsigned tg = og / nx;
            if (og + 1u == (tg + 1u) * nx) xb_add(&bar[XB_TOPGEN], 1u);
            else XB_SPIN(xb_ld(&bar[XB_TOPGEN]) == tg, bar);
            __builtin_amdgcn_fence(__ATOMIC_ACQUIRE, "agent");
            xb_add(&bar[XB_XGEN(b.x)], 1u);
            asm volatile("s_waitcnt vmcnt(0)" ::: "memory");
        } else {
            XB_SPIN(xb_ld(&bar[XB_XGEN(b.x)]) == gen, bar);
            __builtin_amdgcn_fence(__ATOMIC_ACQUIRE, "agent");
            asm volatile("s_waitcnt vmcnt(0)" ::: "memory");
        }
    }
    __syncthreads();
}


#define FRESH(Q) Pm Q = P0; asm volatile("" : "+s"(Q.ws))
__global__ void __launch_bounds__(NTHR) mega_kernel(Pm P0) {
  extern __shared__ __attribute__((aligned(16))) char smem[];
  cg::grid_group grid = cg::this_grid();
  unsigned* barw = (unsigned*)(P0.ws + OFF_BAR);
  if (blockIdx.x == 0) for (int i = threadIdx.x; i < XCD_BAR_WORDS; i += NTHR) barw[i] = 0u;
  if (threadIdx.x == 0) *(uint4*)(smem + 147456) = make_uint4(0u, 0u, 0u, 0u);
  grid.sync();
  XcdBarrier xb = xcd_barrier_post(barw, (volatile LAS unsigned*)(smem + 147456));

  for (int rep_ = 0; rep_ < ((REPEAT_MASK & 128) ? 2 : 1); rep_++) {
  { FRESH(P); phase_mod(P, smem); }
  { FRESH(P); convert_layer(P, 0, smem); }
  }
  xcd_barrier(xb);
  { FRESH(P); rowwise(P, 0, 0); }
  xcd_barrier(xb);

#pragma unroll 1
  for (int l = 0; l < DEPTH; l++) {
    for (int rep_ = 0; rep_ < ((REPEAT_MASK & 1) ? 2 : 1); rep_++) {
      { FRESH(P); gemm_phase256(WSP(bfr, OFF_A), 1024, WBF(W_RW), 1024, T, NRW + NGLA + NRET, 1024, EpiIn{P.ws, smem}, smem); }
    }
    xcd_barrier(xb);
    for (int rep_ = 0; rep_ < ((REPEAT_MASK & 64) ? 2 : 1); rep_++) { FRESH(P); rwkv_lerp(P, l); }
    { FRESH(P); ret_prep(P); }
    for (int rep_ = 0; rep_ < ((REPEAT_MASK & 64) ? 2 : 1); rep_++) { FRESH(P); gla_prep(P, l); }
    xcd_barrier(xb);
    {
      { FRESH(P); gemm_phase(WSP(bfr, OFF_SM) + 0, 320, WBF(W_L2F), 64, T, 1024, 64, EpiDecay{P.in[I_W0] + ((size_t)l * 2 + 0) * 1024, WSP(bfr, OFF_NEF), smem}, smem, 0, 0); }
      { FRESH(P); gemm_phase(WSP(bfr, OFF_SM) + 64, 320, WBF(W_L2B), 64, T, 1024, 64, EpiDecay{P.in[I_W0] + ((size_t)l * 2 + 1) * 1024, WSP(bfr, OFF_NEB), smem}, smem, 544, 0); }
      { FRESH(P); gemm_phase(WSP(bfr, OFF_SM) + 128, 320, WBF(W_LA2), 64, T, 1024, 64,
                 EpiA{P.in[I_A0] + (size_t)l * 1024, P.in[I_KK] + (size_t)l * 1024, P.in[I_KA] + (size_t)l * 1024, WSP(bfr, OFF_KP),
                      WSP(bfr, OFF_KKN), WSP(bfr, OFF_AA)}, smem, 1088, 0); }
      { FRESH(P); gemm_phase(WSP(bfr, OFF_SM) + 192, 320, WBF(W_LG2), 128, T, 1024, 128, EpiBf16{WSP(bfr, OFF_G), 1024, smem}, smem, 1632, 0); }
      if (l > 0) { FRESH(P); gemm_phase(WSP(bfr, OFF_V), 1024, WBF(W_LV1), 1024, T, 128, 1024, EpiBf16{WSP(bfr, OFF_U), 128, smem}, smem, 2176, 0); }
    }
    xcd_barrier(xb);
    if (l > 0) {
      { FRESH(P); gemm_phase(WSP(bfr, OFF_U), 128, WBF(W_LV2), 64, T, 1024, 64,
                 EpiVres{P.in[I_V0] + (size_t)(l - 1) * 1024, WSP(bfr, OFF_V), WSP(bfr, OFF_VF)}, smem, 0, 0); }
      xcd_barrier(xb);
    }
#pragma unroll 1
    for (int rep_ = 0; rep_ < ((REPEAT_MASK & 2) ? 2 : 1); rep_++)
#pragma unroll 1
    for (int u = blockIdx.x; u < 256; u += gridDim.x) {
      if (u < 128) { FRESH(P); if (SIMPLE_SCAN) rwkv_scan_simple(P, u); else rwkv_scan(P, u, smem); }
      else if (u < 192) { for (int r2_ = 0; r2_ < ((REPEAT_MASK & 16) ? 2 : 1); r2_++) { FRESH(P); chunk_scan<1>(P, l, u - 128, smem); } }
      else { for (int r2_ = 0; r2_ < ((REPEAT_MASK & 32) ? 2 : 1); r2_++) { FRESH(P); chunk_scan<2>(P, l, u - 192, smem); } }
    }
    xcd_barrier(xb);
    { FRESH(P); finish(P, l); }
    for (int rep_ = 0; rep_ < ((REPEAT_MASK & 4) ? 2 : 1); rep_++)
    { FRESH(P); gemm_phase256(WSP(bfr, OFF_A), 1024, WBF(W_GATE), 1024, T, NGATE, 1024, EpiSigmoid{WSP(bfr, OFF_PGATE), NGATE, smem}, smem); }
    xcd_barrier(xb);
    for (int rep_ = 0; rep_ < ((REPEAT_MASK & 4) ? 2 : 1); rep_++) {
    { FRESH(P); gemm_phase(WSP(bfr, OFF_OF), 1024, WBF(W_BR), 1024, T, 1024, 1024, EpiBranch{WSP(bfr, OFF_PGATE), WSP(bfr, OFF_MERGED), 0}, smem, 0, 0); }
    { FRESH(P); gemm_phase(WSP(bfr, OFF_OGLA), 1024, WBF(W_BR) + (size_t)1024 * 1024, 1024, T, 1024, 1024, EpiBranch{WSP(bfr, OFF_PGATE), WSP(bfr, OFF_MERGED), 1}, smem, 0, 0); }
    { FRESH(P); gemm_phase(WSP(bfr, OFF_ORET), 1024, WBF(W_BR) + (size_t)2 * 1024 * 1024, 1024, T, 1024, 1024, EpiBranch{WSP(bfr, OFF_PGATE), WSP(bfr, OFF_MERGED), 2}, smem, 0, 0); }
    }
    xcd_barrier(xb);
    for (int rep_ = 0; rep_ < ((REPEAT_MASK & 4) ? 2 : 1); rep_++)
    { FRESH(P); gemm_phase(WSP(bfr, OFF_MERGED), 1024, WBF(W_OUT), 1024, T, 1024, 1024, EpiF32{WSP(float, OFF_Y), 1024}, smem, 0, 0); }
    xcd_barrier(xb);
    { FRESH(P); rowwise(P, 1, l); }
    xcd_barrier(xb);
    for (int rep_ = 0; rep_ < ((REPEAT_MASK & 8) ? 2 : 1); rep_++)
    { FRESH(P); gemm_phase256(WSP(bfr, OFF_A), 1024, WBF(W_1), 1024, T, 4096, 1024, EpiRelu2{WSP(bfr, OFF_H), 4096, smem}, smem); }
    xcd_barrier(xb);
    for (int rep_ = 0; rep_ < ((REPEAT_MASK & 8) ? 2 : 1); rep_++)
    { FRESH(P); gemm_phase(WSP(bfr, OFF_H), 4096, WBF(W_2), 4096, T, 1024, 4096, EpiF32{WSP(float, OFF_Y), 1024}, smem, 0, 0); }
    xcd_barrier(xb);
    { FRESH(P); rowwise(P, 2, l); }
    for (int rep_ = 0; rep_ < ((REPEAT_MASK & 128) ? 2 : 1); rep_++) if (l + 1 < DEPTH) { FRESH(P); convert_layer(P, l + 1, smem); }
    xcd_barrier(xb);
  }
}

extern "C" void kernel_launch(void* const* d_in, const int* in_sizes, int n_in, void* d_out, int out_size, void* d_ws,
                              size_t ws_size, hipStream_t stream) {
  (void)in_sizes; (void)out_size;
  if (n_in < N_IN || ws_size < WS_NEED) {
    fprintf(stderr, "bad args: n_in %d ws %zu need %zu\n", n_in, ws_size, (size_t)WS_NEED);
    return;
  }
  static int grid_blocks = 0;
  if (!grid_blocks) {
    int dev = 0, cus = 0, per_cu = 0;
    hipGetDevice(&dev);
    hipDeviceGetAttribute(&cus, hipDeviceAttributeMultiprocessorCount, dev);
    hipFuncSetAttribute((const void*)mega_kernel, hipFuncAttributeMaxDynamicSharedMemorySize, SMEM_BYTES);
    hipOccupancyMaxActiveBlocksPerMultiprocessor(&per_cu, mega_kernel, NTHR, SMEM_BYTES);
    if (per_cu < 1) per_cu = 1;
    if (per_cu > 1) per_cu = 1;
    grid_blocks = cus * per_cu;
  }
  Pm p;
  memset(&p, 0, sizeof(p));
  for (int i = 0; i < N_IN; i++) p.in[i] = (const float*)d_in[i];
  p.out = (float*)d_out;
  p.ws = (char*)d_ws;
  void* args[] = {&p};
  hipError_t e = hipLaunchCooperativeKernel((void*)mega_kernel, dim3(grid_blocks), dim3(NTHR), args, SMEM_BYTES, stream);
  if (e != hipSuccess) fprintf(stderr, "cooperative launch failed: %s (grid %d)\n", hipGetErrorString(e), grid_blocks);
}
```
